# Optimizing an MI355X kernel written in HIP

```python
import jax
import jax.numpy as jnp
from jax import lax
import numpy as np

D_MODEL = 1024
BATCH = 16
SEQ = 2048
DEPTH = 2

GRID_W = 64
CTX_LEN = 256
N_MOD = 6
EPS = 1e-6
NEG_INF = -1e30

HEAD_DIM = 64
NA_WIDTH = D_MODEL // 2
NA_HEADS = NA_WIDTH // HEAD_DIM
LRU_WIDTH = D_MODEL // 4
LRU_HEADS = 4
LRU_BLOCK = LRU_WIDTH // LRU_HEADS
SC_WIDTH = D_MODEL - NA_WIDTH - LRU_WIDTH

COL_Q = 0
COL_K = COL_Q + NA_WIDTH
COL_V = COL_K + NA_WIDTH
COL_RX = COL_V + NA_WIDTH
COL_RG = COL_RX + LRU_WIDTH
COL_SB = COL_RG + LRU_WIDTH
COL_SC = COL_SB + SC_WIDTH
COL_SX = COL_SC + SC_WIDTH
IN_WIDTH = COL_SX + SC_WIDTH

LRU_CONV = 4
LRU_CONV_LEFT = 2
RG_C = 8.0
SC_CONV = 3
SC_CONV_LEFT = 1
WIN_R = 8
WIN_C = 16
Q_COLS = 16
K_COLS = 32
N_EXPERTS = 16
N_GROUPS = 4
E_PER_GROUP = N_EXPERTS // N_GROUPS
TOP_K = 2
D_EXPERT = 512

kernel_name = 'hybrid_na_rglru_shortconv_moe_dit'


def rms_norm(x, g):
    xf = x.astype(jnp.float32)
    y = xf * lax.rsqrt(jnp.mean(xf * xf, axis=-1, keepdims=True) + EPS)
    return (y * g.astype(jnp.float32)).astype(x.dtype)


def modulate(x, shift, scale):
    return x * (1.0 + scale) + shift


def dwconv(x, w, b, left):
    width, length = w.shape[0], x.shape[1]
    xp = jnp.pad(x, ((0, 0), (left, width - 1 - left), (0, 0)))
    y = xp[:, :length] * w[0] + b
    for k in range(1, width):
        y = y + xp[:, k:k + length] * w[k]
    return y


def _affine_combine(left, right):
    a_l, h_l = left
    a_r, h_r = right
    return a_l * a_r, a_r * h_l + h_r


def linear_scan(a, b, h0, reverse):
    if reverse:
        a, b = jnp.flip(a, 1), jnp.flip(b, 1)
    b = b.at[:, 0].add(a[:, 0] * h0)
    _, h = lax.associative_scan(_affine_combine, (a, b), axis=1)
    return jnp.flip(h, 1) if reverse else h


def rglru_coeffs(xc, w, bias, lam):
    bsz, length, _ = xc.shape
    xb = xc.reshape(bsz, length, LRU_HEADS, LRU_BLOCK)
    pre = jnp.einsum('blnc,gncd->gblnd', xb, w.astype(jnp.float32)).reshape(2, bsz, length, LRU_WIDTH)
    gates = jax.nn.sigmoid(pre + bias.astype(jnp.float32)[:, None, None, :])
    r, i = gates[0], gates[1]
    log_a = -RG_C * r * jax.nn.softplus(-lam.astype(jnp.float32))
    a = jnp.exp(log_a)
    b = jnp.sqrt(-jnp.expm1(2.0 * log_a)) * (i * xc)
    return a, b


def rglru_bidir(x_lat, x_ctx, w, bias, lam, need_ctx):
    y_lat = jnp.zeros_like(x_lat)
    y_ctx = jnp.zeros_like(x_ctx) if need_ctx else None
    for d, rev in enumerate((False, True)):
        a_c, b_c = rglru_coeffs(x_ctx, w[d], bias[d], lam[d])
        h_c = linear_scan(a_c, b_c, jnp.zeros_like(x_ctx[:, 0]), rev)
        a_l, b_l = rglru_coeffs(x_lat, w[d], bias[d], lam[d])
        y_lat = y_lat + linear_scan(a_l, b_l, h_c[:, 0] if rev else h_c[:, -1], rev)
        if need_ctx:
            y_ctx = y_ctx + h_c
    return y_lat, y_ctx


def neighbourhood_attention(q, k, v, kc, vc, rpb):
    bsz, seq, nh, dh = q.shape
    rows = seq // GRID_W
    wr = min(WIN_R, rows)
    ncb = GRID_W // Q_COLS
    scale = dh ** -0.5
    qg = q.reshape(bsz, rows, ncb, Q_COLS, nh, dh)
    kg = k.reshape(bsz, rows, GRID_W, nh, dh)
    vg = v.reshape(bsz, rows, GRID_W, nh, dh)
    q_col = jnp.arange(GRID_W).reshape(ncb, Q_COLS)
    c_start = jnp.clip(q_col - WIN_C // 2, 0, GRID_W - WIN_C)
    k_col = jnp.clip(jnp.arange(ncb) * Q_COLS - WIN_C // 2, 0, GRID_W - K_COLS)[:, None] + jnp.arange(K_COLS)
    col_ok = (k_col[:, None, :] >= c_start[..., None]) & (k_col[:, None, :] < c_start[..., None] + WIN_C)
    rel_c = jnp.clip(k_col[:, None, :] - q_col[..., None] + WIN_C - 1, 0, 2 * WIN_C - 2)
    bias_c = rpb[:, :, rel_c]
    n_loc = wr * K_COLS

    def row_block(r):
        r0 = jnp.clip(r - wr // 2, 0, rows - wr)
        kb = lax.dynamic_slice_in_dim(kg, r0, wr, axis=1)[:, :, k_col]
        vb = lax.dynamic_slice_in_dim(vg, r0, wr, axis=1)[:, :, k_col]
        qr = lax.dynamic_index_in_dim(qg, r, axis=1, keepdims=False)
        bias = jnp.take(bias_c, r0 + jnp.arange(wr) - r + WIN_R - 1, axis=1)
        s_loc = jnp.einsum('bnqhd,brnkhd->bhnqrk', qr, kb, preferred_element_type=jnp.float32) * scale
        s_loc = jnp.where(col_ok[:, :, None, :], s_loc + bias.transpose(0, 2, 3, 1, 4), NEG_INF)
        s_ctx = jnp.einsum('bnqhd,bchd->bhnqc', qr, kc, preferred_element_type=jnp.float32) * scale
        s = jnp.concatenate([s_loc.reshape(bsz, nh, ncb, Q_COLS, n_loc), s_ctx], axis=-1)
        p = jax.nn.softmax(s, axis=-1).astype(v.dtype)
        p_loc = p[..., :n_loc].reshape(bsz, nh, ncb, Q_COLS, wr, K_COLS)
        return (jnp.einsum('bhnqrk,brnkhd->bnqhd', p_loc, vb)
                + jnp.einsum('bhnqc,bchd->bnqhd', p[..., n_loc:], vc))

    out = lax.map(row_block, jnp.arange(rows))
    return jnp.moveaxis(out, 0, 1).reshape(bsz, seq, nh, dh)


def context_attention(qc, kc, vc):
    s = jnp.einsum('bqhd,bkhd->bhqk', qc, kc, preferred_element_type=jnp.float32) * (HEAD_DIM ** -0.5)
    p = jax.nn.softmax(s, axis=-1).astype(vc.dtype)
    return jnp.einsum('bhqk,bkhd->bqhd', p, vc)


def merge_groups(y_na, y_lru, y_sc, g):
    return jnp.concatenate([
        rms_norm(y_na, g[:NA_WIDTH]),
        rms_norm(y_lru, g[NA_WIDTH:NA_WIDTH + LRU_WIDTH]),
        rms_norm(y_sc, g[NA_WIDTH + LRU_WIDTH:])], axis=-1)


def hybrid_mixer(h, hc, w_in, lru_conv_w, lru_conv_b, rg_w, rg_b, rg_lam, rpb,
                 sc_conv_w, sc_conv_b, out_g, w_out, need_ctx):
    bsz, seq, _ = h.shape
    n_ctx = hc.shape[1]
    u = h @ w_in
    c_lo, c_hi = (0, IN_WIDTH) if need_ctx else (COL_K, COL_RG)
    uc = hc @ w_in[:, c_lo:c_hi]

    def lat(lo, hi):
        return u[..., lo:hi]

    def cx(lo, hi):
        return uc[..., lo - c_lo:hi - c_lo]

    def heads(t):
        return t.reshape(t.shape[0], t.shape[1], NA_HEADS, HEAD_DIM)

    kc, vc = heads(cx(COL_K, COL_V)), heads(cx(COL_V, COL_RX))
    y_na = neighbourhood_attention(heads(lat(COL_Q, COL_K)), heads(lat(COL_K, COL_V)),
                                   heads(lat(COL_V, COL_RX)), kc, vc, rpb).reshape(bsz, seq, NA_WIDTH)
    rx = dwconv(lat(COL_RX, COL_RG), lru_conv_w, lru_conv_b, LRU_CONV_LEFT).astype(jnp.float32)
    rxc = dwconv(cx(COL_RX, COL_RG), lru_conv_w, lru_conv_b, LRU_CONV_LEFT).astype(jnp.float32)
    h_lru, h_lru_c = rglru_bidir(rx, rxc, rg_w, rg_b, rg_lam, need_ctx)
    y_lru = h_lru.astype(h.dtype) * jax.nn.gelu(lat(COL_RG, COL_SB))
    y_sc = lat(COL_SB, COL_SC) * dwconv(lat(COL_SC, COL_SX) * lat(COL_SX, IN_WIDTH), sc_conv_w, sc_conv_b, SC_CONV_LEFT)
    y = merge_groups(y_na, y_lru, y_sc, out_g) @ w_out
    if not need_ctx:
        return y, None
    y_na_c = context_attention(heads(cx(COL_Q, COL_K)), kc, vc).reshape(bsz, n_ctx, NA_WIDTH)
    y_lru_c = h_lru_c.astype(hc.dtype) * jax.nn.gelu(cx(COL_RG, COL_SB))
    y_sc_c = cx(COL_SB, COL_SC) * dwconv(cx(COL_SC, COL_SX) * cx(COL_SX, IN_WIDTH), sc_conv_w, sc_conv_b, SC_CONV_LEFT)
    yc = merge_groups(y_na_c, y_lru_c, y_sc_c, out_g) @ w_out
    return y, yc


def moe_ffn(h, w_router, b_router, w_gate, w_up, w_down):
    logits = jnp.einsum('btd,de->bte', h, w_router, preferred_element_type=jnp.float32) + b_router.astype(jnp.float32)
    probs = jax.nn.softmax(logits, axis=-1)
    pg = probs.reshape(*probs.shape[:-1], N_GROUPS, E_PER_GROUP)
    group_score = jnp.sum(lax.top_k(pg, TOP_K)[0], axis=-1)
    g_sel = jnp.argmax(group_score, axis=-1)
    p_in = jnp.take_along_axis(pg, g_sel[..., None, None], axis=-2)[..., 0, :]
    w_top, e_loc = lax.top_k(p_in, TOP_K)
    w_top = w_top / jnp.sum(w_top, axis=-1, keepdims=True)
    e_idx = g_sel[..., None] * E_PER_GROUP + e_loc
    combine = jnp.sum(jax.nn.one_hot(e_idx, N_EXPERTS, dtype=jnp.float32) * w_top[..., None], axis=-2).astype(h.dtype)
    out = jnp.zeros_like(h)
    for e in range(N_EXPERTS):
        hid = jax.nn.silu(h @ w_gate[e]) * (h @ w_up[e])
        out = out + combine[..., e:e + 1] * (hid @ w_down[e])
    return out


def setup_inputs(seed: int = 0) -> dict:
    key = jax.random.key(seed)
    ks = jax.random.split(key, 25)
    L = DEPTH

    def nrm(k, shape, fan_in, gain=1.0):
        return jax.random.normal(k, shape, jnp.float32) * (gain * fan_in ** -0.5)

    def small(k, shape):
        return 0.01 * jax.random.normal(k, shape, jnp.float32)

    def gain(k, shape):
        return 1.0 + 0.02 * jax.random.normal(k, shape, jnp.float32)

    a_pow = jax.random.uniform(ks[12], (L, 2, LRU_WIDTH), jnp.float32, 0.9, 0.999)
    a_base = a_pow ** (1.0 / RG_C)
    return {
        'x': jax.random.normal(ks[0], (BATCH, SEQ, D_MODEL), jnp.float32),
        'c': jax.random.normal(ks[1], (BATCH, D_MODEL), jnp.float32),
        'ctx': jax.random.normal(ks[2], (BATCH, CTX_LEN, D_MODEL), jnp.float32),
        'c_ctx': jax.random.normal(ks[3], (D_MODEL,), jnp.float32),
        'w_ada': nrm(ks[4], (L, D_MODEL, N_MOD * D_MODEL), D_MODEL, 0.5),
        'b_ada': small(ks[5], (L, N_MOD * D_MODEL)),
        'norm_mix_g': gain(ks[6], (L, D_MODEL)),
        'w_in': nrm(ks[7], (L, D_MODEL, IN_WIDTH), D_MODEL),
        'lru_conv_w': nrm(ks[8], (L, LRU_CONV, LRU_WIDTH), LRU_CONV),
        'lru_conv_b': small(ks[9], (L, LRU_WIDTH)),
        'rg_w': nrm(ks[10], (L, 2, 2, LRU_HEADS, LRU_BLOCK, LRU_BLOCK), LRU_BLOCK),
        'rg_b': small(ks[11], (L, 2, 2, LRU_WIDTH)),
        'rg_lam': jnp.log(a_base) - jnp.log1p(-a_base),
        'na_rpb': 0.02 * jax.random.normal(ks[13], (L, NA_HEADS, 2 * WIN_R - 1, 2 * WIN_C - 1), jnp.float32),
        'sc_conv_w': nrm(ks[14], (L, SC_CONV, SC_WIDTH), SC_CONV),
        'sc_conv_b': small(ks[15], (L, SC_WIDTH)),
        'mix_out_g': gain(ks[16], (L, D_MODEL)),
        'w_out': nrm(ks[17], (L, D_MODEL, D_MODEL), D_MODEL),
        'norm_ffn_g': gain(ks[18], (L, D_MODEL)),
        'w_router': nrm(ks[19], (D_MODEL, N_EXPERTS), D_MODEL),
        'b_router': small(ks[20], (N_EXPERTS,)),
        'w_gate': nrm(ks[21], (L, N_EXPERTS, D_MODEL, D_EXPERT), D_MODEL),
        'w_up': nrm(ks[22], (L, N_EXPERTS, D_MODEL, D_EXPERT), D_MODEL),
        'w_down': nrm(ks[23], (L, N_EXPERTS, D_EXPERT, D_MODEL), D_EXPERT),
        'final_g': gain(ks[24], (D_MODEL,)),
    }


def reference(x, c, ctx, c_ctx, w_ada, b_ada, norm_mix_g, w_in, lru_conv_w, lru_conv_b,
              rg_w, rg_b, rg_lam, na_rpb, sc_conv_w, sc_conv_b, mix_out_g, w_out,
              norm_ffn_g, w_router, b_router, w_gate, w_up, w_down, final_g):
    bsz = x.shape[0]
    n_ctx = ctx.shape[1]
    cond = jax.nn.silu(c)
    cond_ctx = jax.nn.silu(c_ctx)
    xc = ctx
    for l in range(DEPTH):
        need_ctx = l < DEPTH - 1
        mod = (cond @ w_ada[l] + b_ada[l]).reshape(bsz, N_MOD, 1, D_MODEL)
        mod_c = (cond_ctx @ w_ada[l] + b_ada[l]).reshape(N_MOD, 1, D_MODEL)
        h = modulate(rms_norm(x, norm_mix_g[l]), mod[:, 0], mod[:, 1])
        hc = modulate(rms_norm(xc, norm_mix_g[l]), mod_c[0], mod_c[1])
        y, yc = hybrid_mixer(h, hc, w_in[l], lru_conv_w[l], lru_conv_b[l], rg_w[l], rg_b[l], rg_lam[l],
                             na_rpb[l], sc_conv_w[l], sc_conv_b[l], mix_out_g[l], w_out[l], need_ctx)
        x = x + mod[:, 2] * y
        h = modulate(rms_norm(x, norm_ffn_g[l]), mod[:, 3], mod[:, 4])
        if need_ctx:
            xc = xc + mod_c[2] * yc
            hc = modulate(rms_norm(xc, norm_ffn_g[l]), mod_c[3], mod_c[4])
            f = moe_ffn(jnp.concatenate([hc, h], axis=1), w_router, b_router, w_gate[l], w_up[l], w_down[l])
            xc = xc + mod_c[5] * f[:, :n_ctx]
            x = x + mod[:, 5] * f[:, n_ctx:]
        else:
            x = x + mod[:, 5] * moe_ffn(h, w_router, b_router, w_gate[l], w_up[l], w_down[l])
    return rms_norm(x, final_g)
```

```cpp
#include <hip/hip_runtime.h>
#include <cstdio>
#include <cstdint>

#ifndef MK_PER_PHASE
#define MK_PER_PHASE 0
#endif

#ifndef REPMASK
#define REPMASK 0
#endif
#define LAS __attribute__((address_space(3)))
#ifndef GU_FP8_MMA
#define GU_FP8_MMA true
#endif
typedef unsigned short bf16_t;
typedef short bf16x8 __attribute__((ext_vector_type(8)));
typedef float f32x4 __attribute__((ext_vector_type(4)));
typedef float f32x2 __attribute__((ext_vector_type(2)));
typedef unsigned u32x4 __attribute__((ext_vector_type(4)));
typedef unsigned u32x2 __attribute__((ext_vector_type(2)));
typedef int i32x8 __attribute__((ext_vector_type(8)));
typedef int i32x4 __attribute__((ext_vector_type(4)));

constexpr int D = 1024, NBATCH = 16, SEQ = 2048, CTXL = 256, GW = 64, NROWS = 32;
constexpr int NLAT = NBATCH * SEQ;
constexpr int NCTX = NBATCH * CTXL;
constexpr int MT = NLAT + NCTX;
constexpr int NMODC = 6 * D;
constexpr int UW = 2080;
constexpr int UQ = 0, UK = 512, URX = 1024, URG = 1280, USB = 1536, UCX = 1792;
constexpr int NBUCK = 24;
constexpr int MPERM = MT + NBUCK * 256;
constexpr float EPSN = 1e-6f;
constexpr float LOG2E = 1.4426950408889634f;

constexpr size_t al256(size_t x) { return (x + 255) & ~(size_t)255; }
constexpr size_t CTL_BYTES = 65536;
constexpr size_t WS_CTL = 0;
constexpr size_t WS_MOD = WS_CTL + CTL_BYTES;
constexpr size_t WS_WIN = WS_MOD + al256((size_t)2 * 17 * 6144 * 4);
constexpr size_t WS_WOUT = WS_WIN + (size_t)2 * 2816 * 1024 * 2;
constexpr size_t WS_WGU = WS_WOUT + (size_t)2 * 1024 * 1024 * 2;
constexpr size_t WS_WD = WS_WGU + (size_t)2 * 16 * 1024 * 1024 * 2;
constexpr size_t WS_RGW = WS_WD + (size_t)2 * 1024 * 8192 * 2;
constexpr size_t WS_TCAR = WS_RGW + (size_t)32 * 4096 * 2;
constexpr size_t WS_TOKINFO = WS_TCAR + (size_t)2 * 144 * 256 * 2 * 4;
constexpr size_t WS_SGU = WS_TOKINFO + (size_t)MT * 16;
constexpr size_t WS_TD = WS_SGU + (size_t)2 * 16 * 1024 * 4;
constexpr size_t WS_ROWW = WS_TD + (size_t)2 * 16 * 512 * 4;
constexpr size_t WS_HS = WS_ROWW + al256((size_t)MPERM * 16);
constexpr size_t WS_H = WS_HS + al256((size_t)MT * 4);
constexpr size_t WS_U = WS_H + (size_t)MT * 1024 * 2;
constexpr size_t U_BYTES = ((size_t)MT * UW * 2 > (size_t)(MPERM + NLAT) * 1024 * 2) ? (size_t)MT * UW * 2 : (size_t)(MPERM + NLAT) * 1024 * 2;
constexpr size_t WS_C = WS_U + U_BYTES;
constexpr size_t WS_VT = WS_C;
constexpr size_t WS_YNA = WS_VT + (size_t)512 * MT * 2;
constexpr size_t WS_HLOC = WS_YNA + (size_t)MT * 512 * 2;
constexpr size_t WS_CUMA = WS_HLOC + (size_t)2 * MT * 256 * 2;
constexpr size_t WS_END = WS_CUMA + (size_t)2 * MT * 256 * 2;
static_assert((size_t)MPERM * 1024 * 2 <= (size_t)MT * UW * 2, "HP fits in U");
static_assert((size_t)MPERM * 1024 * 2 <= WS_END - WS_C, "HID fits in C");
constexpr int CW_BAR = 0;
constexpr int CW_CNT = 4096;
constexpr int CW_CQ = 8192;

constexpr int LDS_STAGE = 131072;
constexpr int LDS_MISC = LDS_STAGE;
constexpr int LDS_BYTES = LDS_STAGE + 16384;

#define XB_TMO      128
#define XB_XCNT(j)  (256  + 64 * (j))
#define XB_XSUB(j)  (1280 + 64 * (j))
#define XB_XGEN(j)  (2304 + 64 * (j))
#define XB_TOP      3328
#define XB_TOPGEN   3392
#define XCD_BAR_WORDS 3456
#define XB_SPIN_CAP (1u << 18)

__device__ __forceinline__ unsigned xb_ld(unsigned* p)              { return __hip_atomic_load(p, __ATOMIC_RELAXED, __HIP_MEMORY_SCOPE_AGENT); }
__device__ __forceinline__ unsigned xb_add(unsigned* p, unsigned v) { return __hip_atomic_fetch_add(p, v, __ATOMIC_RELAXED, __HIP_MEMORY_SCOPE_AGENT); }
__device__ __forceinline__ unsigned xb_xcc_id() { return (unsigned)__builtin_amdgcn_s_getreg((3 << 11) | 20) & 0xFu; }
#define XB_SPIN(cond, bar) do { unsigned _sp = 0; while (cond) { __builtin_amdgcn_s_sleep(1); \
    if ((++_sp & 255u) == 0u) { if (xb_ld(&(bar)[XB_TMO])) break; if (_sp > XB_SPIN_CAP) { atomicAdd(&(bar)[XB_TMO], 1u); break; } } } } while (0)

struct XcdBarrier { unsigned* bar; unsigned x; volatile LAS unsigned* st; };

__device__ __forceinline__ XcdBarrier xcd_barrier_post(unsigned* bar, volatile LAS unsigned* st, int tid0) {
    XcdBarrier b; b.bar = bar; b.x = xb_xcc_id(); b.st = st;
    if (tid0 == 0) (void)xb_add(&bar[XB_XCNT(b.x)], 1u);
    return b;
}
__device__ __forceinline__ void xcd_barrier_complete(unsigned* bar, unsigned x, unsigned& nloc, unsigned& nx) {
    const unsigned G = gridDim.x * gridDim.y * gridDim.z;
    unsigned sum, cnt, mine, sp = 0u;
    for (;;) {
        sum = 0u; cnt = 0u; mine = 0u;
#pragma unroll
        for (unsigned j = 0; j < 16; ++j) { const unsigned c = xb_ld(&bar[XB_XCNT(j)]); sum += c; cnt += (c > 0u) ? 1u : 0u; mine = (j == x) ? c : mine; }
        if (sum == G) break;
        __builtin_amdgcn_s_sleep(1);
        if ((++sp & 255u) == 0u) { if (xb_ld(&bar[XB_TMO])) break; if (sp > XB_SPIN_CAP) { atomicAdd(&bar[XB_TMO], 1u); break; } }
    }
    nloc = mine > 0u ? mine : 1u; nx = cnt > 0u ? cnt : 1u;
}
__device__ __forceinline__ void xcd_barrier(const XcdBarrier& b, int tid0) {
    asm volatile("s_waitcnt vmcnt(0)" ::: "memory");
    __syncthreads();
    if (tid0 == 0) {
        unsigned* bar = b.bar;
        __builtin_amdgcn_s_waitcnt(0);
        unsigned nloc = b.st[0], nx = b.st[1];
        if (nloc == 0u) { xcd_barrier_complete(bar, b.x, nloc, nx); b.st[0] = nloc; b.st[1] = nx; }
        const unsigned old = xb_add(&bar[XB_XSUB(b.x)], 1u);
        const unsigned gen = old / nloc;
        if (old + 1u == (gen + 1u) * nloc) {
            __builtin_amdgcn_fence(__ATOMIC_RELEASE, "agent");
            asm volatile("s_waitcnt vmcnt(0)" ::: "memory");
            const unsigned og = xb_add(&bar[XB_TOP], 1u);
            const unsigned tg = og / nx;
            if (og + 1u == (tg + 1u) * nx) xb_add(&bar[XB_TOPGEN], 1u);
            else XB_SPIN(xb_ld(&bar[XB_TOPGEN]) == tg, bar);
            __builtin_amdgcn_fence(__ATOMIC_ACQUIRE, "agent");
            xb_add(&bar[XB_XGEN(b.x)], 1u);
            asm volatile("s_waitcnt vmcnt(0)" ::: "memory");
        } else {
            XB_SPIN(xb_ld(&bar[XB_XGEN(b.x)]) == gen, bar);
            __builtin_amdgcn_fence(__ATOMIC_ACQUIRE, "agent");
            asm volatile("s_waitcnt vmcnt(0)" ::: "memory");
        }
    }
    __syncthreads();
}

typedef __bf16 bf16v2_t __attribute__((ext_vector_type(2)));
__device__ __forceinline__ unsigned cvt_pk_bf16(float lo, float hi) { const f32x2 v = {lo, hi}; const bf16v2_t b = __builtin_convertvector(v, bf16v2_t); return __builtin_bit_cast(unsigned, b); }
__device__ __forceinline__ float bf_lo(unsigned w) { return __uint_as_float(w << 16); }
__device__ __forceinline__ float bf_hi(unsigned w) { return __uint_as_float(w & 0xffff0000u); }
__device__ __forceinline__ float bf2f(bf16_t h) { return __uint_as_float(((unsigned)h) << 16); }
__device__ __forceinline__ bf16_t f2bf(float f) { return (bf16_t)(cvt_pk_bf16(f, 0.f) & 0xffffu); }
template <int CTRL, int ROWMASK> __device__ __forceinline__ float dpp_f(float v) { return __builtin_bit_cast(float, __builtin_amdgcn_update_dpp(0, __builtin_bit_cast(int, v), CTRL, ROWMASK, 0xF, false)); }
__device__ __forceinline__ float wave_sum(float v) {
    v += dpp_f<0xB1, 0xF>(v); v += dpp_f<0x4E, 0xF>(v); v += dpp_f<0x141, 0xF>(v); v += dpp_f<0x140, 0xF>(v);
    v += dpp_f<0x142, 0xA>(v); v += dpp_f<0x143, 0xC>(v);
    return __builtin_bit_cast(float, __builtin_amdgcn_readlane(__builtin_bit_cast(int, v), 63));
}
__device__ __forceinline__ float wave_max(float v) {
    v = fmaxf(v, dpp_f<0xB1, 0xF>(v)); v = fmaxf(v, dpp_f<0x4E, 0xF>(v)); v = fmaxf(v, dpp_f<0x141, 0xF>(v)); v = fmaxf(v, dpp_f<0x140, 0xF>(v));
    v = fmaxf(v, dpp_f<0x142, 0xA>(v)); v = fmaxf(v, dpp_f<0x143, 0xC>(v));
    return __builtin_bit_cast(float, __builtin_amdgcn_readlane(__builtin_bit_cast(int, v), 63));
}
__device__ __forceinline__ unsigned cvt_fp8x4(float a, float b, float c, float d) {
    int w = 0; w = __builtin_amdgcn_cvt_pk_fp8_f32(a, b, w, false); w = __builtin_amdgcn_cvt_pk_fp8_f32(c, d, w, true); return (unsigned)w; }
constexpr float FP8_TOP = 440.0f;
constexpr float HID_CH = 64.0f;
__device__ __forceinline__ float sigmoidf_(float x) { return __builtin_amdgcn_rcpf(1.0f + __builtin_amdgcn_exp2f(-x * LOG2E)); }
__device__ __forceinline__ float gelu_tanh(float x) {
    const float u = 0.7978845608028654f * (x + 0.044715f * x * x * x);
    return x * sigmoidf_(2.0f * u);
}

struct KArgs { const float* in[25]; float* out; unsigned char* ws; int ph_lo, ph_hi; };
typedef const KArgs __attribute__((address_space(4)))* KAp;
__device__ __forceinline__ KAp ka_get() { KAp p = (KAp)__builtin_amdgcn_kernarg_segment_ptr(); asm volatile("" : "+s"(p)); return p; }

__device__ __forceinline__ int lane_id_() { unsigned z = 0u; asm volatile("" : "+v"(z)); return (int)__builtin_amdgcn_mbcnt_hi(~0u, __builtin_amdgcn_mbcnt_lo(~0u, z)); }
__device__ __forceinline__ int op_tid_w(int wv) { int t = wv * 64 + lane_id_(); asm volatile("" : "+v"(t)); return t; }
#define op_tid() op_tid_w(wv)
__device__ __forceinline__ int op_blk() { int t = blockIdx.x; asm volatile("" : "+s"(t)); return t; }
__device__ __forceinline__ int op_grid() { int t = gridDim.x; asm volatile("" : "+s"(t)); return t; }

namespace pg8 {
constexpr int BM = 256, BK = 64, HALF = 128, HTB = HALF * BK * 2, STAGE_BYTES = 8 * HTB;
__host__ __device__ __forceinline__ int lds_byte(int r, int c) { const int st = (r >> 4) * 2 + (c >> 5), rr = r & 15, cc = c & 31, ob = rr * 64 + cc * 2; return st * 1024 + (ob ^ (((ob >> 9) & 1) << 5)); }
__host__ __device__ __forceinline__ void stage_rc(int b, int& R, int& C) { const int st = b / 1024, sb = b % 1024, swz = sb ^ (((sb >> 9) & 1) << 5); R = (st >> 1) * 16 + swz / 64; C = (st & 1) * 32 + (swz % 64) / 2; }
__host__ __device__ __forceinline__ int perm32(int rho) { const int n = rho >> 4, i = rho & 15; return 8 * (i >> 2) + 4 * n + (i & 3); }

struct Unit { const char* a; const char* b0; const char* b1; int pm, pn, x0, x1; };

#ifndef PG8_SP2
#define PG8_SP2 true
#endif
#ifndef PG8_ALIGN
#define PG8_ALIGN true
#endif
template <class Epi, class Sched, bool FP8 = false, bool GATHER = false, bool SP2 = PG8_SP2, bool ALIGN_EPI = PG8_ALIGN>
__device__ __forceinline__ void gemm_phase(const int wv, LAS unsigned char* lds, const int K, const int lda, const int ldb, const Sched& S, const Epi& E) {
    const int tid = op_tid(), wid = __builtin_amdgcn_readfirstlane(tid >> 6), lane = tid & 63, wr = wid >> 2, wc = wid & 3, fr = lane & 15, fq = lane >> 4;
    const int nt = K / BK, nth = nt / 2;
    unsigned voffA[2], voffB[2];
#pragma unroll
    for (int i = 0; i < 2; ++i) { int R, C; stage_rc(tid * 16 + i * 8192, R, C); const int Rb = Epi::PERM ? ((R & ~31) + perm32(R & 31)) : R;
        voffA[i] = (unsigned)(R * lda + C) * 2u; voffB[i] = (unsigned)(Rb * ldb + C) * 2u; }
    const size_t kstep = (size_t)(BK * 2);
    const size_t hstepA = (size_t)HALF * lda * 2, hstepB = (size_t)HALF * ldb * 2;
    const unsigned ldsw = (unsigned)wid * 1024u;
    const int aoff = lds_byte(wr * 64 + fr, fq * 8), boff = lds_byte(wc * 32 + fr, fq * 8);
#define PG8_SA(b, h) (((b) * 2 + (h)) * HTB)
#define PG8_SB(b, h) ((4 + (b) * 2 + (h)) * HTB)
#define PG8_STAGE(bufoff, gbase, voff) do { _Pragma("unroll") for (int _i = 0; _i < 2; ++_i) \
        __builtin_amdgcn_global_load_lds((const unsigned*)((const char*)(gbase) + (voff)[_i]), (LAS unsigned*)(lds + (bufoff) + ldsw + _i * 8192), 16, 0, 0); } while (0)
#define PG8_LDA(dst, b, h) do { _Pragma("unroll") for (int m = 0; m < 4; ++m) _Pragma("unroll") for (int k = 0; k < 2; ++k) dst[m].k[k] = *(const LAS bf16x8*)(lds + PG8_SA(b, h) + aoff + m * 2048 + k * 1024); } while (0)
#define PG8_LDB(dst, b, h) do { _Pragma("unroll") for (int n = 0; n < 2; ++n) _Pragma("unroll") for (int k = 0; k < 2; ++k) dst[n].k[k] = *(const LAS bf16x8*)(lds + PG8_SB(b, h) + boff + n * 2048 + k * 1024); } while (0)
#define PG8_MMA(ai, bj, At, Bt) do { __builtin_amdgcn_s_setprio(1); _Pragma("unroll") for (int m = 0; m < 4; ++m) _Pragma("unroll") for (int n = 0; n < 2; ++n) { \
        if (FP8) { i32x8 b8_ = __builtin_bit_cast(i32x8, Bt[n]), a8_ = __builtin_bit_cast(i32x8, At[m]); \
              \
              \
            asm volatile("v_mfma_f32_16x16x128_f8f6f4 %0, %1, %2, %0" : "+v"(acc[ai][bj][m][n]) : "v"(b8_), "v"(a8_)); } \
        else { _Pragma("unroll") for (int k = 0; k < 2; ++k) acc[ai][bj][m][n] = __builtin_amdgcn_mfma_f32_16x16x32_bf16(Bt[n].k[k], At[m].k[k], acc[ai][bj][m][n], 0, 0, 0); } } \
        __builtin_amdgcn_s_setprio(0); } while (0)
#define PG8_WAIT_V(n) asm volatile("s_waitcnt vmcnt(" #n ")" ::: "memory")
#define PG8_WAIT_L(n) asm volatile("s_waitcnt lgkmcnt(" #n ")" ::: "memory")
#define PG8_BAR __builtin_amdgcn_s_barrier()
#define PG8_SCHED __builtin_amdgcn_sched_barrier(0)
    Unit cur, nxt; int ui = 0;
    if (!S.next(0, cur)) return;
    f32x4 acc[2][2][4][2];
#pragma unroll
    for (int a = 0; a < 2; ++a)
#pragma unroll
        for (int b = 0; b < 2; ++b)
#pragma unroll
            for (int m = 0; m < 4; ++m)
#pragma unroll
                for (int n = 0; n < 2; ++n) acc[a][b][m][n] = (f32x4){0.f, 0.f, 0.f, 0.f};
    struct Frag2 { bf16x8 k[2]; };
    Frag2 At[4], B0[2], B1[2];
    const char* cA = cur.a; const char* cB = cur.b0; const char* cB1 = cur.b1;
    static_assert(!GATHER || SP2, "gather mode: SP2 K-loop only");
    unsigned vA0[2] = {0u, 0u}, vA1[2] = {0u, 0u}, nA0[2] = {0u, 0u}, nA1[2] = {0u, 0u};
#define PG8_GOFFS(u, o0, o1) do { const int rb_ = (u).x1 & 0xFFFFF, valid_ = (u).x1 >> 20; _Pragma("unroll") for (int i_ = 0; i_ < 2; ++i_) { int R_, C_; stage_rc(tid * 16 + i_ * 8192, R_, C_); \
        const int t0_ = __float_as_int(S.rw[rb_ + (R_ < valid_ ? R_ : 0)][3]), t1_ = __float_as_int(S.rw[rb_ + (R_ + 128 < valid_ ? R_ + 128 : 0)][3]); \
        o0[i_] = (unsigned)t0_ * (unsigned)(lda * 2) + (unsigned)C_ * 2u; o1[i_] = (unsigned)t1_ * (unsigned)(lda * 2) + (unsigned)C_ * 2u; } } while (0)
#define PG8_STAGE_A(b, h, base, o0, o1) do { if constexpr (GATHER) { if (h) PG8_STAGE(PG8_SA(b, h), base, o1); else PG8_STAGE(PG8_SA(b, h), base, o0); } \
        else PG8_STAGE(PG8_SA(b, h), (base) + ((h) ? hstepA : (size_t)0), voffA); } while (0)
    if constexpr (GATHER) PG8_GOFFS(cur, vA0, vA1);
    if constexpr (SP2) {
        PG8_STAGE(PG8_SB(0, 0), cB, voffB); PG8_STAGE(PG8_SB(0, 1), cB + hstepB, voffB); PG8_STAGE_A(0, 0, cA, vA0, vA1); PG8_STAGE_A(0, 1, cA, vA0, vA1);
        if (wr == 1) PG8_BAR;
        PG8_WAIT_V(2); PG8_BAR;
        PG8_STAGE(PG8_SB(1, 0), cB + kstep, voffB); PG8_STAGE_A(1, 0, cA + kstep, vA0, vA1); PG8_STAGE(PG8_SB(1, 1), cB + hstepB + kstep, voffB);
        PG8_WAIT_V(6); PG8_BAR;
    } else {
    PG8_STAGE(PG8_SB(0, 0), cB, voffB); PG8_STAGE(PG8_SA(0, 0), cA, voffA); PG8_STAGE(PG8_SB(0, 1), cB + hstepB, voffB); PG8_STAGE(PG8_SA(0, 1), cA + hstepA, voffA);
    if (wr == 1) PG8_BAR;
    PG8_WAIT_V(4); PG8_BAR;
    PG8_STAGE(PG8_SB(1, 0), cB + kstep, voffB); PG8_STAGE(PG8_SA(1, 0), cA + kstep, voffA); PG8_STAGE(PG8_SB(1, 1), cB + hstepB + kstep, voffB);
    PG8_WAIT_V(6); PG8_BAR;
    }
    for (;;) {
        const bool has_next = S.next(ui + 1, nxt);
        const char* nA = has_next ? nxt.a : cA; const char* nB = has_next ? nxt.b0 : cB;
        if constexpr (GATHER) { if (has_next) PG8_GOFFS(nxt, nA0, nA1); else { nA0[0] = vA0[0]; nA0[1] = vA0[1]; nA1[0] = vA1[0]; nA1[1] = vA1[1]; } }
#pragma nounroll
        for (int t = 0; t < nt; t += 2) {
            const bool last = (t == nt - 2);
            const int t2 = t + 2;
            const char* a1 = cA + (size_t)(t + 1) * kstep;
            const char* bc2 = (t2 < nth) ? cB + (size_t)t2 * kstep : cB1 + (size_t)(t2 - nth) * kstep;
            const char* a2 = last ? nA : cA + (size_t)t2 * kstep; const char* b2 = last ? nB : bc2;
            const char* a3 = a2 + kstep; const char* b3 = b2 + kstep;
            unsigned sA0[2], sA1[2];
            if constexpr (GATHER) { sA0[0] = last ? nA0[0] : vA0[0]; sA0[1] = last ? nA0[1] : vA0[1]; sA1[0] = last ? nA1[0] : vA1[0]; sA1[1] = last ? nA1[1] : vA1[1]; }
            if constexpr (SP2) {
            PG8_LDB(B0, 0, 0); PG8_LDB(B1, 0, 1); PG8_SCHED; PG8_LDA(At, 0, 0); PG8_STAGE_A(1, 1, a1, vA0, vA1);
            PG8_WAIT_V(8); PG8_WAIT_L(0); PG8_BAR; PG8_MMA(0, 0, At, B0); PG8_MMA(0, 1, At, B1); PG8_BAR; PG8_SCHED;
            PG8_LDA(At, 0, 1); PG8_STAGE(PG8_SB(0, 0), b2, voffB); PG8_STAGE(PG8_SB(0, 1), b2 + hstepB, voffB); PG8_STAGE_A(0, 0, a2, sA0, sA1);
            PG8_WAIT_V(8); PG8_WAIT_L(0); PG8_BAR; PG8_MMA(1, 0, At, B0); PG8_MMA(1, 1, At, B1); PG8_BAR; PG8_SCHED;
            PG8_LDB(B0, 1, 0); PG8_LDB(B1, 1, 1); PG8_SCHED; PG8_LDA(At, 1, 0); PG8_STAGE_A(0, 1, a2, sA0, sA1);
            PG8_WAIT_V(8); PG8_WAIT_L(0); PG8_BAR; PG8_MMA(0, 0, At, B0); PG8_MMA(0, 1, At, B1); PG8_BAR; PG8_SCHED;
            PG8_LDA(At, 1, 1); PG8_STAGE(PG8_SB(1, 0), b3, voffB); PG8_STAGE(PG8_SB(1, 1), b3 + hstepB, voffB); PG8_STAGE_A(1, 0, a3, sA0, sA1);
            PG8_WAIT_V(8); PG8_WAIT_L(0); PG8_BAR; PG8_MMA(1, 0, At, B0); PG8_MMA(1, 1, At, B1); PG8_BAR; PG8_SCHED;
            } else {
            PG8_LDB(B0, 0, 0); PG8_SCHED; PG8_LDA(At, 0, 0); PG8_STAGE(PG8_SA(1, 1), a1 + hstepA, voffA);
            PG8_WAIT_L(8); PG8_BAR; PG8_WAIT_L(0); PG8_MMA(0, 0, At, B0); PG8_BAR; PG8_SCHED;
            PG8_LDB(B1, 0, 1); PG8_STAGE(PG8_SB(0, 0), b2, voffB);
            PG8_BAR; PG8_WAIT_L(0); PG8_MMA(0, 1, At, B1); PG8_BAR;
            PG8_LDA(At, 0, 1); PG8_STAGE(PG8_SA(0, 0), a2, voffA);
            PG8_BAR; PG8_WAIT_L(0); PG8_MMA(1, 0, At, B0); PG8_BAR; PG8_SCHED;
            PG8_STAGE(PG8_SB(0, 1), b2 + hstepB, voffB);
            PG8_WAIT_V(6); PG8_BAR; PG8_MMA(1, 1, At, B1); PG8_BAR;
            PG8_LDB(B0, 1, 0); PG8_SCHED; PG8_LDA(At, 1, 0); PG8_STAGE(PG8_SA(0, 1), a2 + hstepA, voffA);
            PG8_WAIT_L(8); PG8_BAR; PG8_WAIT_L(0); PG8_MMA(0, 0, At, B0); PG8_BAR; PG8_SCHED;
            PG8_LDB(B1, 1, 1); PG8_STAGE(PG8_SB(1, 0), b3, voffB);
            PG8_BAR; PG8_WAIT_L(0); PG8_MMA(0, 1, At, B1); PG8_BAR;
            PG8_LDA(At, 1, 1); PG8_STAGE(PG8_SA(1, 0), a3, voffA);
            PG8_BAR; PG8_WAIT_L(0); PG8_MMA(1, 0, At, B0); PG8_BAR; PG8_SCHED;
            PG8_STAGE(PG8_SB(1, 1), b3 + hstepB, voffB);
            PG8_WAIT_V(6); PG8_BAR; PG8_MMA(1, 1, At, B1); PG8_BAR;
            }
        }
        if constexpr (ALIGN_EPI) { if (wr == 0) PG8_BAR; }
        if (FP8) asm volatile("s_nop 15\n\ts_nop 15\n\ts_nop 7" ::: "memory");
        { int fr_ = fr, fq_ = fq; asm volatile("" : "+v"(fr_), "+v"(fq_));
          E(acc, cur, wr, wc, fr_, fq_); }
        if (FP8) asm volatile("s_nop 3" ::: "memory");
        if (!has_next) break;
#pragma unroll
        for (int a = 0; a < 2; ++a)
#pragma unroll
            for (int b = 0; b < 2; ++b)
#pragma unroll
                for (int m = 0; m < 4; ++m)
#pragma unroll
                    for (int n = 0; n < 2; ++n) acc[a][b][m][n] = (f32x4){0.f, 0.f, 0.f, 0.f};
        cur = nxt; cA = cur.a; cB = cur.b0; cB1 = cur.b1; ++ui;
        if constexpr (GATHER) { vA0[0] = nA0[0]; vA0[1] = nA0[1]; vA1[0] = nA1[0]; vA1[1] = nA1[1]; }
        if constexpr (ALIGN_EPI) { if (wr == 1) PG8_BAR; }
    }
    PG8_WAIT_V(0);
    if constexpr (!ALIGN_EPI) { if (wr == 0) PG8_BAR; }
    PG8_BAR;
#undef PG8_SA
#undef PG8_SB
#undef PG8_STAGE
#undef PG8_STAGE_A
#undef PG8_GOFFS
#undef PG8_LDA
#undef PG8_LDB
#undef PG8_MMA
#undef PG8_WAIT_V
#undef PG8_WAIT_L
#undef PG8_BAR
#undef PG8_SCHED
}

__device__ __forceinline__ void tile_order(int L, int nM, int nN, int& pm, int& pn) {
    const int nwg = nM * nN; int wgid = L;
    { const int q = nwg / 8, r = nwg % 8, xcd = wgid % 8, off = wgid / 8; wgid = (xcd < r ? xcd * (q + 1) : r * (q + 1) + (xcd - r) * q) + off; }
    const int nig = 8 * nN, gid = wgid / nig, fm = gid * 8, gsz = (nM - fm) < 8 ? (nM - fm) : 8;
    pm = fm + ((wgid % nig) % gsz); pn = (wgid % nig) / gsz;
}
}

struct SchedInproj {
    int G, c, nrt; const char* H; const char* Win; int skipctx;
    __device__ __forceinline__ bool next(int i, pg8::Unit& u) const {
        const int L = i * G + c, nfull = skipctx ? 128 : nrt, n0 = nfull * 9, n1 = n0 + (skipctx ? 16 * 3 : 0);
        if (L < n1) { int pm, pn;
            if (L < n0) pg8::tile_order(L, nfull, 9, pm, pn); else { const int q = L - n0; pm = 128 + q / 3; pn = 2 + q % 3; }
            u.a = H + (size_t)pm * (256 * 2048); const int brow = pn < 4 ? pn * 256 : 1536 + (pn - 4) * 256;
            u.b0 = Win + (size_t)brow * 2048; u.b1 = u.b0 + 1024; u.pm = pm; u.pn = pn; u.x0 = 0; u.x1 = 0; return true; }
        const int L2 = L - n1; if (L2 >= 2 * nrt) return false;
        const int x8 = L2 & 7, q8 = L2 >> 3, pa = q8 & 1, pt = x8 * (nrt >> 3) + (q8 >> 1);
        u.a = Win + (size_t)(1024 + pa * 256) * 2048; u.b0 = H + (size_t)pt * (256 * 2048); u.b1 = u.b0 + 1024; u.pm = pa; u.pn = pt; u.x0 = 1; u.x1 = 0; return true;
    }
};
struct EpiInproj {
    static constexpr bool PERM = true;
    bf16_t* U; bf16_t* VT;
    __device__ __forceinline__ void operator()(const f32x4 (&acc)[2][2][4][2], const pg8::Unit& u, int wr, int wc, int fr, int fq) const {
        const int row0 = wr * 64 + fr, col0 = wc * 32 + 8 * fq;
        if (u.x0 == 0 && u.pn >= 7) {
            bf16_t* cb = U + (size_t)u.pm * 256 * UW + UCX + (u.pn - 7) * 128 + col0;
#pragma unroll
            for (int ai = 0; ai < 2; ++ai)
#pragma unroll
                for (int m = 0; m < 4; ++m) { const f32x4 a0 = acc[ai][0][m][0] * acc[ai][1][m][0], a1 = acc[ai][0][m][1] * acc[ai][1][m][1];
                    u32x4 w; w.x = cvt_pk_bf16(a0[0], a0[1]); w.y = cvt_pk_bf16(a0[2], a0[3]); w.z = cvt_pk_bf16(a1[0], a1[1]); w.w = cvt_pk_bf16(a1[2], a1[3]);
                    *(u32x4*)(cb + (size_t)(row0 + ai * 128 + m * 16) * UW) = w; }
            return;
        }
#pragma unroll
        for (int ai = 0; ai < 2; ++ai)
#pragma unroll
            for (int m = 0; m < 4; ++m) { const int rr = row0 + ai * 128 + m * 16;
                bf16_t* rowp = u.x0 == 0 ? U + (size_t)(u.pm * 256 + rr) * UW + u.pn * 256 + col0
                                         : VT + (size_t)((u.pm * 256 + rr) >> 1) * (2 * MT) + (size_t)(u.pn * 8 + wc) * 64 + (rr & 1) * 32 + 8 * fq;
#pragma unroll
                for (int bj = 0; bj < 2; ++bj) { const f32x4 v0 = acc[ai][bj][m][0], v1 = acc[ai][bj][m][1];
                    u32x4 w; w.x = cvt_pk_bf16(v0[0], v0[1]); w.y = cvt_pk_bf16(v0[2], v0[3]); w.z = cvt_pk_bf16(v1[0], v1[1]); w.w = cvt_pk_bf16(v1[2], v1[3]);
                    *(u32x4*)(rowp + (u.x0 == 0 ? bj * 128 : bj * 256)) = w; } }
    }
};
struct SchedOut {
    int G, c, nrt; const char* A; const char* W;
    __device__ __forceinline__ bool next(int i, pg8::Unit& u) const {
        const int L = i * G + c; if (L >= nrt * 4) return false;
        int pm, pn; pg8::tile_order(L, nrt, 4, pm, pn);
        u.a = A + (size_t)pm * (256 * 2048); u.b0 = W + (size_t)pn * (256 * 2048); u.b1 = u.b0 + 1024; u.pm = pm; u.pn = pn; u.x0 = 0; u.x1 = 0; return true;
    }
};
struct EpiStore {
    static constexpr bool PERM = true;
    bf16_t* Y;
    __device__ __forceinline__ void operator()(const f32x4 (&acc)[2][2][4][2], const pg8::Unit& u, int wr, int wc, int fr, int fq) const {
        bf16_t* base = Y + (size_t)u.pm * 256 * D + u.pn * 256;
        const int row0 = wr * 64 + fr, col0 = wc * 32 + 8 * fq;
#pragma unroll
        for (int ai = 0; ai < 2; ++ai)
#pragma unroll
            for (int m = 0; m < 4; ++m) { bf16_t* rowp = base + (size_t)(row0 + ai * 128 + m * 16) * D + col0;
#pragma unroll
                for (int bj = 0; bj < 2; ++bj) { const f32x4 v0 = acc[ai][bj][m][0], v1 = acc[ai][bj][m][1];
                    u32x4 w; w.x = cvt_pk_bf16(v0[0], v0[1]); w.y = cvt_pk_bf16(v0[2], v0[3]); w.z = cvt_pk_bf16(v1[0], v1[1]); w.w = cvt_pk_bf16(v1[2], v1[3]);
                    *(u32x4*)(rowp + bj * 128) = w; } }
    }
};
struct EpiStoreS {
    static constexpr bool PERM = true;
    bf16_t* Y; float mul;
    __device__ __forceinline__ void operator()(const f32x4 (&acc)[2][2][4][2], const pg8::Unit& u, int wr, int wc, int fr, int fq) const {
        bf16_t* base = Y + (size_t)u.pm * 256 * D + u.pn * 256;
        const int row0 = wr * 64 + fr, col0 = wc * 32 + 8 * fq;
#pragma unroll
        for (int ai = 0; ai < 2; ++ai)
#pragma unroll
            for (int m = 0; m < 4; ++m) { bf16_t* rowp = base + (size_t)(row0 + ai * 128 + m * 16) * D + col0;
#pragma unroll
                for (int bj = 0; bj < 2; ++bj) { const f32x4 v0 = acc[ai][bj][m][0] * mul, v1 = acc[ai][bj][m][1] * mul;
                    u32x4 w; w.x = cvt_pk_bf16(v0[0], v0[1]); w.y = cvt_pk_bf16(v0[2], v0[3]); w.z = cvt_pk_bf16(v1[0], v1[1]); w.w = cvt_pk_bf16(v1[2], v1[3]);
                    *(u32x4*)(rowp + bj * 128) = w; } }
    }
};
struct SchedMoe {
    int G, c, NU, ntiles; const LAS int* tst;
    const char* A; const char* W; int down; const f32x4* rw;
    __device__ __forceinline__ bool next(int i, pg8::Unit& u) const {
        int mt, pn;
        if ((G & 7) == 0) {
            const int x = c & 7, q = i * (G >> 3) + (c >> 3), t = q / NU; pn = q - t * NU; mt = t * 8 + x;
            if (mt >= ntiles) return false;
        } else { const int L = i * G + c; if (L >= ntiles * NU) return false; mt = L / NU; pn = L - mt * NU; }
        const int bk = __builtin_amdgcn_readfirstlane(tst[32 + mt]);
        const int grp = bk / 6, p = bk - grp * 6;
        const int lo = p < 3 ? 0 : (p < 5 ? 1 : 2), hi = p < 3 ? p + 1 : (p < 5 ? p - 1 : 3);
        const int elo = grp * 4 + lo, ehi = grp * 4 + hi;
        u.a = A + (size_t)mt * (256 * 2048); u.pm = mt; u.pn = pn; u.x0 = 0; u.x1 = 0;
        if (!down) { const int which = pn >> 2, j = pn & 3; const int e = which ? ehi : elo;
            u.b0 = W + (size_t)e * (1024 * 1024) + (size_t)j * (256 * 1024); u.b1 = u.b0 + 512; u.x0 = e; u.a = A;
            const int jt = mt - tst[bk], left = tst[208 + bk] - jt * 256; u.x1 = (bk * MT + jt * 256) | ((left < 256 ? left : 256) << 20); }
        else { const char* wb = W + (size_t)pn * 256 * 512; u.b0 = wb + (size_t)elo * (1024 * 512); u.b1 = wb + (size_t)ehi * (1024 * 512); u.a = A + (size_t)mt * (256 * 1024); }
        return true;
    }
};
struct EpiGateUp {
    static constexpr bool PERM = true;
    unsigned char* HID; const f32x4* roww; const float* sgu; const float* tdl;
    __device__ __forceinline__ void operator()(const f32x4 (&acc)[2][2][4][2], const pg8::Unit& u, int wr, int wc, int fr, int fq) const {
        const int which = u.pn >> 2, j = u.pn & 3, cf = j * 128 + wc * 32 + 8 * fq;
        const int prow0 = u.pm * 256 + wr * 64 + fr, col0 = which * 512 + cf;
        const float* sp = sgu + (size_t)u.x0 * 1024 + j * 256 + wc * 32 + 8 * fq;
        const float* tq = tdl + (size_t)u.x0 * 512 + cf;
        const f32x4 sg0 = *(const f32x4*)sp, sg1 = *(const f32x4*)(sp + 4), ut0 = *(const f32x4*)(sp + 128) * *(const f32x4*)tq, ut1 = *(const f32x4*)(sp + 132) * *(const f32x4*)(tq + 4);
        f32x4 rw[8];
#pragma unroll
        for (int i = 0; i < 8; ++i) rw[i] = roww[(u.x1 & 0xFFFFF) + wr * 64 + fr + (i >> 2) * 128 + (i & 3) * 16];
#pragma unroll
        for (int ai = 0; ai < 2; ++ai)
#pragma unroll
            for (int m = 0; m < 4; ++m) { const int prow = prow0 + ai * 128 + m * 16; const f32x4 w4 = rw[ai * 4 + m]; const float w = which ? w4[1] : w4[0], sa = w4[2];
                const float nsa = -sa * LOG2E, rc = sa * sa * w;
                u32x2 pk;
#pragma unroll
                for (int n = 0; n < 2; ++n) { const f32x4 Gp = acc[ai][0][m][n] * (n ? sg1 : sg0), Up = acc[ai][1][m][n] * (n ? ut1 : ut0);
                    const f32x4 P = (Gp * Up) * rc, ar = Gp * nsa; f32x4 den;
#pragma unroll
                    for (int e = 0; e < 4; ++e) den[e] = __builtin_amdgcn_exp2f(ar[e]);
                    den = den + 1.0f;
#pragma unroll
                    for (int e = 0; e < 4; ++e) den[e] = __builtin_amdgcn_rcpf(den[e]);
                    const f32x4 o = P * den;
                    const unsigned q = cvt_fp8x4(__builtin_amdgcn_fmed3f(o[0], -448.0f, 448.0f), __builtin_amdgcn_fmed3f(o[1], -448.0f, 448.0f), __builtin_amdgcn_fmed3f(o[2], -448.0f, 448.0f), __builtin_amdgcn_fmed3f(o[3], -448.0f, 448.0f));
                    if (n) pk.y = q; else pk.x = q; }
                *(u32x2*)(HID + (size_t)prow * 1024 + col0) = pk; }
    }
};


__device__ __forceinline__ void transpose_job(const float* src, int sld, bf16_t* dst, int dld, LAS float* tile, int tid) {
    { const int c4 = (tid & 15) * 4, r = tid >> 4;
#pragma unroll
      for (int p = 0; p < 2; ++p) { const int rr = r + p * 32; const f32x4 v = *(const f32x4*)(src + (size_t)rr * sld + c4);
          tile[rr * 65 + c4 + 0] = v[0]; tile[rr * 65 + c4 + 1] = v[1]; tile[rr * 65 + c4 + 2] = v[2]; tile[rr * 65 + c4 + 3] = v[3]; } }
    __syncthreads();
    { const int n = tid >> 3, k8 = (tid & 7) * 8; float f[8];
#pragma unroll
      for (int j = 0; j < 8; ++j) f[j] = tile[(k8 + j) * 65 + n];
      u32x4 w; w.x = cvt_pk_bf16(f[0], f[1]); w.y = cvt_pk_bf16(f[2], f[3]); w.z = cvt_pk_bf16(f[4], f[5]); w.w = cvt_pk_bf16(f[6], f[7]);
      *(u32x4*)(dst + (size_t)n * dld + k8) = w; }
    __syncthreads();
}
constexpr int NCONV_LAYER = 176 + 64;
struct ConvJob { const float* src; bf16_t* dst; int sld, dld; };
__device__ __forceinline__ ConvJob conv_decode(KAp ap, int g, int tid) {
    const int ly = g >= NCONV_LAYER ? 1 : 0, J = g - ly * NCONV_LAYER, kg = tid & 7, cg = tid >> 3;
    unsigned char* ws = ap->ws; ConvJob c;
    if (J < 176) { const int kt = J / 11, nt = J - kt * 11, ns = nt * 256 + 4 * cg; int nd = ns;
        if (ns >= 2304) { const int sx = ns >= 2560, j = ns - (sx ? 2560 : 2304); nd = 2304 + (j >> 7) * 256 + sx * 128 + (j & 127); }
        c.sld = 2816; c.dld = 1024;
        c.src = ap->in[7] + (size_t)ly * 1024 * 2816 + (size_t)(kt * 64 + 8 * kg) * 2816 + ns;
        c.dst = (bf16_t*)(ws + WS_WIN) + (size_t)ly * 2816 * 1024 + (size_t)nd * 1024 + kt * 64 + 8 * kg; }
    else { const int r = J - 176, kt = r >> 2, n = (r & 3) * 256 + 4 * cg;
        c.sld = 1024; c.dld = 1024;
        c.src = ap->in[17] + (size_t)ly * 1048576 + (size_t)(kt * 64 + 8 * kg) * 1024 + n;
        c.dst = (bf16_t*)(ws + WS_WOUT) + (size_t)ly * 1048576 + (size_t)n * 1024 + kt * 64 + 8 * kg; }
    return c;
}
__device__ __forceinline__ void conv_load(const ConvJob& c, f32x4 (&v)[8]) {
#pragma unroll
    for (int i = 0; i < 8; ++i) v[i] = __builtin_nontemporal_load((const f32x4*)(c.src + (size_t)i * c.sld));
}
__device__ __forceinline__ void conv_store(const ConvJob& c, const f32x4 (&v)[8]) {
#pragma unroll
    for (int j = 0; j < 4; ++j) { u32x4 w; w.x = cvt_pk_bf16(v[0][j], v[1][j]); w.y = cvt_pk_bf16(v[2][j], v[3][j]); w.z = cvt_pk_bf16(v[4][j], v[5][j]); w.w = cvt_pk_bf16(v[6][j], v[7][j]);
        *(u32x4*)(c.dst + (size_t)j * c.dld) = w; }
}
constexpr int NGU8_LAYER = 512;
__device__ __forceinline__ void q8_job(KAp ap, LAS unsigned char* lds, int g8, int tid) {
    unsigned char* ws = ap->ws;
    const int ly = g8 >= NGU8_LAYER ? 1 : 0, jidx = g8 - ly * NGU8_LAYER, up = jidx >> 8, e = (jidx >> 4) & 15, cb = jidx & 15, le = ly * 16 + e;
    const int n0 = cb * 32, row0 = (n0 >> 7) * 256 + up * 128 + (n0 & 127);
    const int c4 = (tid & 7) * 4, r = tid >> 3;
    const float* src = ap->in[up ? 22 : 21] + (size_t)le * (1024 * 512) + cb * 32 + (size_t)(16 * r) * 512 + c4;
    unsigned char* dst = ws + WS_WGU + ((size_t)le * 1024 + row0 + c4) * 1024 + 16 * r; float* scp = (float*)(ws + WS_SGU) + (size_t)le * 1024 + row0;
    LAS float* red = (LAS float*)lds;
    LAS float* inv = (LAS float*)(lds + 1024);
    f32x4 v[16];
#pragma unroll
    for (int i = 0; i < 16; ++i) v[i] = __builtin_nontemporal_load((const f32x4*)(src + (size_t)i * 512));
    f32x4 mx = (f32x4){0.f, 0.f, 0.f, 0.f};
#pragma unroll
    for (int i = 0; i < 16; ++i) { mx[0] = fmaxf(mx[0], fabsf(v[i][0])); mx[1] = fmaxf(mx[1], fabsf(v[i][1])); mx[2] = fmaxf(mx[2], fabsf(v[i][2])); mx[3] = fmaxf(mx[3], fabsf(v[i][3])); }
#pragma unroll
    for (int o = 8; o < 64; o <<= 1) { mx[0] = fmaxf(mx[0], __shfl_xor(mx[0], o)); mx[1] = fmaxf(mx[1], __shfl_xor(mx[1], o)); mx[2] = fmaxf(mx[2], __shfl_xor(mx[2], o)); mx[3] = fmaxf(mx[3], __shfl_xor(mx[3], o)); }
    __syncthreads();
    if ((tid & 63) < 8) *(LAS f32x4*)(red + (tid >> 6) * 32 + c4) = mx;
    __syncthreads();
    if (tid < 32) { float m = 0.f;
#pragma unroll
        for (int w = 0; w < 8; ++w) m = fmaxf(m, red[w * 32 + tid]);
        const float sc = m > 0.f ? m * (1.0f / FP8_TOP) : 1.0f; scp[tid] = sc; inv[tid] = 1.0f / sc; }
    __syncthreads();
    const f32x4 iv = *(const LAS f32x4*)(inv + c4);
#pragma unroll
    for (int j = 0; j < 4; ++j) { u32x4 w;
        w.x = cvt_fp8x4(v[0][j] * iv[j], v[1][j] * iv[j], v[2][j] * iv[j], v[3][j] * iv[j]); w.y = cvt_fp8x4(v[4][j] * iv[j], v[5][j] * iv[j], v[6][j] * iv[j], v[7][j] * iv[j]);
        w.z = cvt_fp8x4(v[8][j] * iv[j], v[9][j] * iv[j], v[10][j] * iv[j], v[11][j] * iv[j]); w.w = cvt_fp8x4(v[12][j] * iv[j], v[13][j] * iv[j], v[14][j] * iv[j], v[15][j] * iv[j]);
        *(u32x4*)(dst + (size_t)j * 1024) = w; }
}
constexpr int NGD8_LAYER = 256;
__device__ __forceinline__ void q8d_job(KAp ap, LAS unsigned char* lds, int gd, int tid) {
    unsigned char* ws = ap->ws;
    const int le = gd >> 4, kb = gd & 15, c = tid & 255, kh = tid >> 8;
    const float* src = ap->in[23] + (size_t)le * (512 * 1024) + (size_t)(kb * 32 + kh * 16) * 1024 + 4 * c;
    unsigned char* dst = ws + WS_WD + (size_t)le * (1024 * 512) + (size_t)(4 * c) * 512 + kb * 32 + kh * 16;
    float* tp = (float*)(ws + WS_TD) + (size_t)le * 512 + kb * 32;
    LAS float* red = (LAS float*)lds;
    LAS float* tf = (LAS float*)(lds + 1024);
    f32x4 v[16];
#pragma unroll
    for (int i = 0; i < 16; ++i) v[i] = __builtin_nontemporal_load((const f32x4*)(src + (size_t)i * 1024));
    float mr[16];
#pragma unroll
    for (int i = 0; i < 16; ++i) mr[i] = wave_max(fmaxf(fmaxf(fabsf(v[i][0]), fabsf(v[i][1])), fmaxf(fabsf(v[i][2]), fabsf(v[i][3]))));
    __syncthreads();
    if ((tid & 63) == 0) {
#pragma unroll
        for (int i = 0; i < 16; i += 4) *(LAS f32x4*)(red + (tid >> 6) * 16 + i) = (f32x4){mr[i], mr[i + 1], mr[i + 2], mr[i + 3]}; }
    __syncthreads();
    if (tid < 32) { const int h = tid >> 4, i = tid & 15; float m = 0.f;
#pragma unroll
        for (int w = 0; w < 4; ++w) m = fmaxf(m, red[(h * 4 + w) * 16 + i]);
        const float t = m > 0.f ? m : 1.0f; tp[tid] = t * HID_CH; tf[tid] = FP8_TOP / t; }
    __syncthreads();
    float f[16];
#pragma unroll
    for (int i = 0; i < 16; i += 4) { const f32x4 q = *(const LAS f32x4*)(tf + kh * 16 + i); f[i] = q[0]; f[i + 1] = q[1]; f[i + 2] = q[2]; f[i + 3] = q[3]; }
#pragma unroll
    for (int j = 0; j < 4; ++j) { u32x4 w;
        w.x = cvt_fp8x4(v[0][j] * f[0], v[1][j] * f[1], v[2][j] * f[2], v[3][j] * f[3]); w.y = cvt_fp8x4(v[4][j] * f[4], v[5][j] * f[5], v[6][j] * f[6], v[7][j] * f[7]);
        w.z = cvt_fp8x4(v[8][j] * f[8], v[9][j] * f[9], v[10][j] * f[10], v[11][j] * f[11]); w.w = cvt_fp8x4(v[12][j] * f[12], v[13][j] * f[13], v[14][j] * f[14], v[15][j] * f[15]);
        *(u32x4*)(dst + (size_t)j * 512) = w; }
}
__device__ __forceinline__ void convert_jobs(KAp ap, int jlo, int jhi, int rank, int nworkers, int tid) {
    for (int J = jlo + rank; J < jhi; J += 2 * nworkers) {
        const ConvJob c0 = conv_decode(ap, J, tid), c1 = conv_decode(ap, J + nworkers < jhi ? J + nworkers : J, tid);
        f32x4 v0[8], v1[8]; conv_load(c0, v0); conv_load(c1, v1); conv_store(c0, v0); conv_store(c1, v1); }
}
constexpr int CQ0 = 176, CQ1 = 240, CQ2 = 2 * NCONV_LAYER;
constexpr int CH1 = 640, CH2 = 704;
constexpr int CD1 = 384;
__device__ __forceinline__ void convert_queue(KAp ap, LAS unsigned char* lds, int lo, int hi, int qi, int tid) {
    unsigned* ctr = (unsigned*)(ap->ws + WS_CTL) + CW_CQ + qi * 64;
    volatile LAS unsigned* slot = (volatile LAS unsigned*)(lds + LDS_MISC + 64);
    unsigned nxt = 0; if (tid == 0) nxt = atomicAdd(ctr, 2u);
    for (;;) {
        __syncthreads();
        if (tid == 0) slot[0] = nxt;
        __syncthreads();
        const int base = lo + (int)slot[0];
        if (base >= hi) break;
        if (tid == 0) nxt = atomicAdd(ctr, 2u);
        const ConvJob c0 = conv_decode(ap, base, tid), c1 = conv_decode(ap, base + 1 < hi ? base + 1 : base, tid);
        f32x4 v0[8], v1[8]; conv_load(c0, v0); conv_load(c1, v1); conv_store(c0, v0); conv_store(c1, v1);
    }
}
template <bool DOWN = false>
__device__ __forceinline__ void gu8_queue(KAp ap, LAS unsigned char* lds, int lo, int hi, int qi, int tid) {
    unsigned* ctr = (unsigned*)(ap->ws + WS_CTL) + CW_CQ + qi * 64;
    volatile LAS unsigned* slot = (volatile LAS unsigned*)(lds + LDS_MISC + 64);
    for (;;) {
        __syncthreads();
        if (tid == 0) slot[0] = atomicAdd(ctr, 1u);
        __syncthreads();
        const int j = lo + (int)slot[0];
        if (j >= hi) break;
        if (DOWN) q8d_job(ap, lds, j, tid); else q8_job(ap, lds, j, tid);
    }
}
__device__ __forceinline__ void p0_phase(KAp ap, LAS unsigned char* lds, int tid, int G, int blk) {
    unsigned char* ws = ap->ws;
    LAS float* cond = (LAS float*)lds;
    LAS float* red = (LAS float*)(lds + 69632);
    { f32x4 cv[9];
#pragma unroll
      for (int p = 0; p < 9; ++p) { const int i4 = tid + 512 * p, j4 = i4 < 4352 ? i4 : 4351; cv[p] = *(const f32x4*)(j4 < 4096 ? ap->in[1] + j4 * 4 : ap->in[3] + (j4 - 4096) * 4); }
      __builtin_amdgcn_sched_barrier(0);
#pragma unroll
      for (int p = 0; p < 9; ++p) { const int i4 = tid + 512 * p; if (i4 < 4352) { f32x4 v = cv[p]; v[0] *= sigmoidf_(v[0]); v[1] *= sigmoidf_(v[1]); v[2] *= sigmoidf_(v[2]); v[3] *= sigmoidf_(v[3]); *(LAS f32x4*)(cond + i4 * 4) = v; } } }
    __syncthreads();
    float* mod = (float*)(ws + WS_MOD);
    for (int job = blk; job < 256; job += G) {
        const int l = job >> 7, col0 = (job & 127) * 48;
        if (tid < 384) { const int col = tid % 48, ks = tid / 48; float acc[17];
#pragma unroll
            for (int r = 0; r < 17; ++r) acc[r] = 0.f;
            const float* wp = ap->in[4] + (size_t)l * 1024 * NMODC + (size_t)(ks * 128) * NMODC + col0 + col;
            float wc[16], wn[16];
#pragma unroll
            for (int j = 0; j < 16; ++j) wc[j] = wp[(size_t)j * NMODC];
#pragma nounroll
            for (int k0 = 0; k0 < 128; k0 += 16) {
                const int kn = k0 + 16 < 128 ? k0 + 16 : k0;
#pragma unroll
                for (int j = 0; j < 16; ++j) wn[j] = wp[(size_t)(kn + j) * NMODC];
                __builtin_amdgcn_sched_barrier(0);
#pragma unroll
                for (int j = 0; j < 16; ++j)
#pragma unroll
                    for (int r = 0; r < 17; ++r) acc[r] += cond[r * 1024 + ks * 128 + k0 + j] * wc[j];
                __builtin_amdgcn_sched_barrier(0);
#pragma unroll
                for (int j = 0; j < 16; ++j) wc[j] = wn[j];
            }
#pragma unroll
            for (int r = 0; r < 17; ++r) red[(ks * 17 + r) * 48 + col] = acc[r]; }
        __syncthreads();
        for (int i = tid; i < 17 * 48; i += 512) { const int r = i / 48, col = i % 48; float s = ap->in[5][l * NMODC + col0 + col];
#pragma unroll
            for (int ks = 0; ks < 8; ++ks) s += red[(ks * 17 + r) * 48 + col];
            mod[(size_t)(l * 17 + r) * NMODC + col0 + col] = s; }
        __syncthreads();
    }
    convert_jobs(ap, 0, CQ0, blk, G, tid);

    { bf16_t* rgw = (bf16_t*)(ws + WS_RGW); LAS float* tile = (LAS float*)lds;
      for (int m = blk; m < 32; m += G) transpose_job(ap->in[10] + (size_t)m * 4096, 64, rgw + (size_t)m * 4096, 64, tile, tid); }
}

__device__ __forceinline__ void route_decide(const float (&lg)[16], int& bucket, float& wlo, float& whi) {
    float mx = lg[0];
#pragma unroll
    for (int e = 1; e < 16; ++e) mx = fmaxf(mx, lg[e]);
    float p[16];
#pragma unroll
    for (int e = 0; e < 16; ++e) p[e] = __expf(lg[e] - mx);
    int gsel = 0; float gbest = -1.f;
#pragma unroll
    for (int g = 0; g < 4; ++g) { const float a0 = p[4 * g], a1 = p[4 * g + 1], a2 = p[4 * g + 2], a3 = p[4 * g + 3];
        const float h1 = fmaxf(a0, a1), l1 = fminf(a0, a1), h2 = fmaxf(a2, a3), l2 = fminf(a2, a3);
        const float top = fmaxf(h1, h2), sec = fmaxf(fminf(h1, h2), fmaxf(l1, l2));
        const float sc2 = top + sec; if (sc2 > gbest) { gbest = sc2; gsel = g; } }
    float q0 = 0.f, q1 = 0.f, q2 = 0.f, q3 = 0.f;
#pragma unroll
    for (int g = 0; g < 4; ++g) if (g == gsel) { q0 = p[4 * g]; q1 = p[4 * g + 1]; q2 = p[4 * g + 2]; q3 = p[4 * g + 3]; }
    int i1 = 0; float b1 = q0; if (q1 > b1) { b1 = q1; i1 = 1; } if (q2 > b1) { b1 = q2; i1 = 2; } if (q3 > b1) { b1 = q3; i1 = 3; }
    int i2 = -1; float b2 = -1.f;
    if (i1 != 0 && q0 > b2) { b2 = q0; i2 = 0; } if (i1 != 1 && q1 > b2) { b2 = q1; i2 = 1; } if (i1 != 2 && q2 > b2) { b2 = q2; i2 = 2; } if (i1 != 3 && q3 > b2) { b2 = q3; i2 = 3; }
    const int lo = i1 < i2 ? i1 : i2, hi = i1 < i2 ? i2 : i1;
    const float inv = 1.0f / (b1 + b2);
    wlo = (lo == i1 ? b1 : b2) * inv; whi = (hi == i1 ? b1 : b2) * inv;
    const int pidx = lo == 0 ? hi - 1 : (lo == 1 ? hi + 1 : 5);
    bucket = gsel * 6 + pidx;
}
struct RnArgs {
    const float* xl; const float* xc;
    const bf16_t* xs16; bf16_t* xd16;
    const bf16_t* Y; const float* gatev;
    const u32x4* tokinfo_prev; const unsigned* gcnt_prev;
    const float* gvec; const float* modl; bf16_t* H; float* outf;
    f32x4* rw;
    unsigned char* H8; float* HS;
    const float* wrt; const float* brt; unsigned* gcnt; u32x4* tokinfo;
    int gi, si, ntok;
};
template <int RES, bool ROUTER, bool FINAL, bool SRC16>
__device__ __forceinline__ void resnorm_phase(const RnArgs& A, LAS unsigned char* lds, int tid, int G, int blk) {
    const int wave = __builtin_amdgcn_readfirstlane(tid >> 6), lane = tid & 63;
    constexpr int HP_ = 1032;
    LAS bf16_t* hbuf = (LAS bf16_t*)lds;
    constexpr int B2 = 66560;
    LAS int* lcnt = (LAS int*)(lds + B2);
    LAS int* lbase = (LAS int*)(lds + B2 + 128);
    LAS int* tstp = (LAS int*)(lds + B2 + 256);
    LAS u32x4* tokbuf = (LAS u32x4*)(lds + B2 + 512);
    LAS float* part = (LAS float*)(lds + B2 + 4096);
    LAS float* mv = (LAS float*)(lds + B2 + 12288);
    const int ntok = A.ntok, chunk = (ntok + G - 1) / G, t0 = blk * chunk, t1 = (t0 + chunk < ntok) ? t0 + chunk : ntok;
    if (ROUTER) { if (tid < 32) lcnt[tid] = 0; }
    if (RES == 2) { if (tid < 64) { const int n = tid < NBUCK ? (int)((A.gcnt_prev[tid] + 255u) >> 8) : 0; int inc = n;
#pragma unroll
            for (int o = 1; o < 32; o <<= 1) { const int t = __shfl_up(inc, o); if (tid >= o) inc += t; }
            if (tid < NBUCK) tstp[tid] = inc - n; } }
    if (ROUTER || RES == 2) __syncthreads();
    f32x4 gv4[4];
#pragma unroll
    for (int j = 0; j < 4; ++j) gv4[j] = *(const f32x4*)(A.gvec + j * 256 + lane * 4);
    bf16x8 Bh[4], Bl[4];
    if (ROUTER) {
#pragma unroll
        for (int ks = 0; ks < 4; ++ks) { const float* wp = A.wrt + (size_t)(wave * 128 + ks * 32 + (lane >> 4) * 8) * 16 + (lane & 15);
            float f[8], g[8];
#pragma unroll
            for (int j = 0; j < 8; ++j) { f[j] = wp[j * 16]; g[j] = f[j] - bf_lo(cvt_pk_bf16(f[j], 0.f)); }
            union { u32x4 u; bf16x8 b; } h_, l_;
            h_.u.x = cvt_pk_bf16(f[0], f[1]); h_.u.y = cvt_pk_bf16(f[2], f[3]); h_.u.z = cvt_pk_bf16(f[4], f[5]); h_.u.w = cvt_pk_bf16(f[6], f[7]);
            l_.u.x = cvt_pk_bf16(g[0], g[1]); l_.u.y = cvt_pk_bf16(g[2], g[3]); l_.u.z = cvt_pk_bf16(g[4], g[5]); l_.u.w = cvt_pk_bf16(g[6], g[7]);
            Bh[ks] = h_.b; Bl[ks] = l_.b; }
    }
    float rb = 0.f; if (ROUTER) rb = A.brt[lane & 15];
    f32x4 xv[4], xn[4]; u32x2 yv[4], yn[4];
#define RN_LOAD(row, X, Yv) do { \
        if (SRC16) { const bf16_t* xp_ = A.xs16 + (size_t)(row) * D; _Pragma("unroll") for (int j = 0; j < 4; ++j) { const u32x2 w_ = *(const u32x2*)(xp_ + j * 256 + lane * 4); X[j] = (f32x4){bf_lo(w_.x), bf_hi(w_.x), bf_lo(w_.y), bf_hi(w_.y)}; } } \
        else { const float* xp_ = (row) < NLAT ? A.xl + (size_t)(row) * D : A.xc + (size_t)((row) - NLAT) * D; \
            _Pragma("unroll") for (int j = 0; j < 4; ++j) X[j] = *(const f32x4*)(xp_ + j * 256 + lane * 4); } \
        if (RES == 1) { const bf16_t* yp_ = A.Y + (size_t)(row) * D; _Pragma("unroll") for (int j = 0; j < 4; ++j) Yv[j] = *(const u32x2*)(yp_ + j * 256 + lane * 4); } \
        if (RES == 2) { const u32x4 ti_ = tin; const bf16_t* yp_ = A.Y + (size_t)(tstp[ti_.x] * 256 + (int)ti_.y) * D; \
            _Pragma("unroll") for (int j = 0; j < 4; ++j) Yv[j] = *(const u32x2*)(yp_ + j * 256 + lane * 4); \
            tin = A.tokinfo_prev[(row) + 8 < s1 ? (row) + 8 : s1 - 1]; } } while (0)
    for (int s0 = t0; s0 < t1; ) {
        const int mrow = s0 < NLAT ? (s0 >> 11) : 16;
        const int bnd = s0 < NLAT ? ((s0 >> 11) + 1) << 11 : ntok, s1 = bnd < t1 ? bnd : t1;
        __syncthreads();
        for (int i = tid; i < 768; i += 512) { const int a = i >> 8, k4 = (i & 255) * 4;
            const float* src = (a == 0) ? A.gatev + (size_t)mrow * NMODC + A.gi * D : A.modl + (size_t)mrow * NMODC + (A.si + a - 1) * D;
            f32x4 w = (f32x4){0.f, 0.f, 0.f, 0.f}; if ((a == 0) ? (RES != 0) : !FINAL) w = *(const f32x4*)(src + k4);
            *(LAS f32x4*)(mv + a * 1024 + k4) = w; }
        __syncthreads();
        const int niter = (s1 - s0 + 7) >> 3;
        int row = s0 + wave;
        u32x4 tin = (u32x4){0u, 0u, 0u, 0u}; if (RES == 2 && row < s1) tin = A.tokinfo_prev[row];
        if (row < s1) RN_LOAD(row, xv, yv);
        for (int it = 0; it < niter; ++it, row += 8) {
            if (row < s1) {
                const int nrow = row + 8 < s1 ? row + 8 : s1 - 1;
                RN_LOAD(nrow, xn, yn);
                f32x4 v[4]; float ss = 0.f;
#pragma unroll
                for (int j = 0; j < 4; ++j) { v[j] = xv[j];
                    if (RES != 0) { const f32x4 gg = *(const LAS f32x4*)(mv + j * 256 + lane * 4);
                        v[j][0] += gg[0] * bf_lo(yv[j].x); v[j][1] += gg[1] * bf_hi(yv[j].x); v[j][2] += gg[2] * bf_lo(yv[j].y); v[j][3] += gg[3] * bf_hi(yv[j].y);
                        if (!FINAL) { u32x2 w; w.x = cvt_pk_bf16(v[j][0], v[j][1]); w.y = cvt_pk_bf16(v[j][2], v[j][3]); *(u32x2*)(A.xd16 + (size_t)row * D + j * 256 + lane * 4) = w; } }
                    ss += v[j][0] * v[j][0] + v[j][1] * v[j][1] + v[j][2] * v[j][2] + v[j][3] * v[j][3]; }
                ss = wave_sum(ss);
                const float rstd = rsqrtf(ss * (1.0f / D) + EPSN);
                if (FINAL) {
#pragma unroll
                    for (int j = 0; j < 4; ++j) *(f32x4*)(A.outf + (size_t)row * D + j * 256 + lane * 4) = v[j] * rstd * gv4[j];
                } else {
#pragma unroll
                    for (int j = 0; j < 4; ++j) { const int k = j * 256 + lane * 4; const f32x4 sh = *(const LAS f32x4*)(mv + 1024 + k), sc = *(const LAS f32x4*)(mv + 2048 + k);
                        v[j] = (v[j] * rstd * gv4[j]) * (1.0f + sc) + sh;
                        if (!ROUTER) { u32x2 w; w.x = cvt_pk_bf16(v[j][0], v[j][1]); w.y = cvt_pk_bf16(v[j][2], v[j][3]); *(u32x2*)(A.H + (size_t)row * D + k) = w; } }
                    if (ROUTER) {
                        float am = 0.f;
#pragma unroll
                        for (int j = 0; j < 4; ++j) am = fmaxf(am, fmaxf(fmaxf(fabsf(v[j][0]), fabsf(v[j][1])), fmaxf(fabsf(v[j][2]), fabsf(v[j][3]))));
                        am = wave_max(am);
                        const float sa = am > 0.f ? am * (1.0f / FP8_TOP) : 1.0f, ia = 1.0f / sa;
                        LAS bf16_t* hr = hbuf + ((it & 1) * 8 + wave) * HP_ + lane * 4;
#pragma unroll
                        for (int j = 0; j < 4; ++j) { *(unsigned*)(A.H8 + (size_t)row * D + j * 256 + lane * 4) = cvt_fp8x4(v[j][0] * ia, v[j][1] * ia, v[j][2] * ia, v[j][3] * ia);
                            u32x2 hi; hi.x = cvt_pk_bf16(v[j][0], v[j][1]); hi.y = cvt_pk_bf16(v[j][2], v[j][3]);
                            u32x2 lo; lo.x = cvt_pk_bf16(v[j][0] - bf_lo(hi.x), v[j][1] - bf_hi(hi.x)); lo.y = cvt_pk_bf16(v[j][2] - bf_lo(hi.y), v[j][3] - bf_hi(hi.y));
                            *(LAS u32x2*)(hr + j * 256) = hi; *(LAS u32x2*)(hr + 16 * HP_ + j * 256) = lo; }
                        if (lane == 0) A.HS[row] = sa;
                    }
                }
#pragma unroll
                for (int j = 0; j < 4; ++j) { xv[j] = xn[j]; yv[j] = yn[j]; }
            }
            if (ROUTER && ((it & 1) || it == niter - 1)) {
                __syncthreads();
                { const int n16 = lane & 15, kg = lane >> 4; f32x4 acc = (f32x4){0.f, 0.f, 0.f, 0.f};
#pragma unroll
                  for (int ks = 0; ks < 4; ++ks) { const LAS bf16_t* ap = hbuf + n16 * HP_ + wave * 128 + ks * 32 + kg * 8;
                      const bf16x8 ah = *(const LAS bf16x8*)ap, al = *(const LAS bf16x8*)(ap + 16 * HP_);
                      acc = __builtin_amdgcn_mfma_f32_16x16x32_bf16(ah, Bh[ks], acc, 0, 0, 0);
                      acc = __builtin_amdgcn_mfma_f32_16x16x32_bf16(ah, Bl[ks], acc, 0, 0, 0);
                      acc = __builtin_amdgcn_mfma_f32_16x16x32_bf16(al, Bh[ks], acc, 0, 0, 0); }
#pragma unroll
                  for (int e = 0; e < 4; ++e) part[(wave * 16 + kg * 4 + e) * 16 + n16] = acc[e]; }
                __syncthreads();
                const int rb0 = s0 + (it >> 1) * 16;
                if (tid < 256) {
                    const int r16 = tid >> 4, x = tid & 15; float lgx = rb;
#pragma unroll
                    for (int w = 0; w < 8; ++w) lgx += part[(w * 16 + r16) * 16 + x];
                    float lg[16];
#pragma unroll
                    for (int e = 0; e < 16; ++e) lg[e] = __shfl(lgx, (lane & 48) + e);
                    if (rb0 + r16 < s1) { int bk; float wl_, wh_; route_decide(lg, bk, wl_, wh_);
                        if (x == 0) { const int ls = atomicAdd((int*)(lcnt + bk), 1); tokbuf[rb0 + r16 - t0] = (u32x4){(unsigned)bk, (unsigned)ls, __float_as_uint(wl_), __float_as_uint(wh_)}; } }
                }
            }
        }
        s0 = s1;
    }
#undef RN_LOAD
    if (ROUTER) {
        __syncthreads();
        if (tid < NBUCK) { const int n = lcnt[tid]; lbase[tid] = n > 0 ? (int)atomicAdd(A.gcnt + tid, (unsigned)n) : 0; }
        __syncthreads();
        for (int i = tid; i < t1 - t0; i += 512) { u32x4 t = tokbuf[i]; t.y += (unsigned)lbase[t.x]; A.tokinfo[t0 + i] = t;
            A.rw[(size_t)t.x * MT + t.y] = (f32x4){__uint_as_float(t.z), __uint_as_float(t.w), A.HS[t0 + i], __int_as_float(t0 + i)}; }
    }
}

__device__ __forceinline__ void moe_offsets(const unsigned* gcnt, LAS int* tst  , int tid) {
    if (tid < 64) {
        const int n = tid < NBUCK ? (int)((gcnt[tid] + 255u) >> 8) : 0; int inc = n;
#pragma unroll
        for (int o = 1; o < 32; o <<= 1) { const int t = __shfl_up(inc, o); if (tid >= o) inc += t; }
        if (tid < NBUCK) { tst[tid] = inc - n; tst[208 + tid] = (int)gcnt[tid]; } if (tid == NBUCK - 1) tst[NBUCK] = inc; }
    __syncthreads();
    if (tid < MPERM / 256) { int bk = 0; for (int b = 1; b < NBUCK; ++b) bk += (tst[b] <= tid) ? 1 : 0; tst[32 + tid] = bk; }
    __syncthreads();
}
__device__ __forceinline__ void permute_phase(const unsigned char* H8, const float* HS, unsigned char* HP8, const u32x4* tokinfo, const unsigned* gcnt, f32x4* roww, int ntok, LAS int* tst, int tid, int G, int blk) {
    const int wave = __builtin_amdgcn_readfirstlane(tid >> 6), lane = tid & 63;
    moe_offsets(gcnt, tst, tid);
    const int stride = G * 8; int row = blk * 8 + wave;
    u32x4 ti = (u32x4){0u, 0u, 0u, 0u}, tin = ti, a0 = ti; float hs = 0.f;
    if (row < ntok) { ti = tokinfo[row]; a0 = ((const u32x4*)(H8 + (size_t)row * D))[lane]; hs = HS[row]; }
    if (row + stride < ntok) tin = tokinfo[row + stride];
    for (; row < ntok; row += stride) {
        const u32x4 tc = ti, c0 = a0; const float hc = hs; ti = tin;
        { const int r1 = row + stride < ntok ? row + stride : ntok - 1, r2 = row + 2 * stride < ntok ? row + 2 * stride : ntok - 1;
          a0 = ((const u32x4*)(H8 + (size_t)r1 * D))[lane]; hs = HS[r1]; tin = tokinfo[r2]; }
        const int dest = tst[tc.x] * 256 + (int)tc.y;
        ((u32x4*)(HP8 + (size_t)dest * D))[lane] = c0;
        if (lane == 0) roww[dest] = (f32x4){__uint_as_float(tc.z), __uint_as_float(tc.w), hc, 0.f};
    }
}

struct AttnKV { bf16x8 k[2][2]; bf16x8 v[4]; };
__device__ __forceinline__ void attn_load(AttnKV& kv, const bf16_t* U, const bf16_t* VT, int tokbase, int h, unsigned klo, unsigned vlo) {
    const bf16_t* kb = U + (size_t)tokbase * UW + UK + h * 64;
    kv.k[0][0] = *(const bf16x8*)(kb + klo); kv.k[0][1] = *(const bf16x8*)(kb + 32 + klo);
    kv.k[1][0] = *(const bf16x8*)(kb + 4 * UW + klo); kv.k[1][1] = *(const bf16x8*)(kb + 4 * UW + 32 + klo);
    const bf16_t* vb = VT + (size_t)(h * 64) * MT + (size_t)tokbase * 2;
#pragma unroll
    for (int db = 0; db < 4; ++db) kv.v[db] = *(const bf16x8*)(vb + (size_t)db * 16 * MT + vlo);
}
template <bool LOCAL, int HALF>
__device__ __forceinline__ void attn_step(const AttnKV& kv, const bf16x8 q0, const bf16x8 q1, f32x4 (&O)[4], float& m, float& l, const bool first, const LAS float* bptr, const LAS f32x4* mptr) {
    const f32x4 z = (f32x4){0.f, 0.f, 0.f, 0.f};
    f32x4 s0 = __builtin_amdgcn_mfma_f32_16x16x32_bf16(kv.k[0][0], q0, z, 0, 0, 0); s0 = __builtin_amdgcn_mfma_f32_16x16x32_bf16(kv.k[0][1], q1, s0, 0, 0, 0);
    f32x4 s1 = __builtin_amdgcn_mfma_f32_16x16x32_bf16(kv.k[1][0], q0, z, 0, 0, 0); s1 = __builtin_amdgcn_mfma_f32_16x16x32_bf16(kv.k[1][1], q1, s1, 0, 0, 0);
    float t[8]; const float nm = -m;
#pragma unroll
    for (int e = 0; e < 8; ++e) { const float sv = e < 4 ? s0[e & 3] : s1[e & 3];
        t[e] = __builtin_fmaf(sv, 0.125f * LOG2E, nm);
        if (LOCAL) t[e] = (t[e] + bptr[HALF * 32 + (e >> 2) * 4 + (e & 3)]) + ((const LAS float*)mptr)[(e >> 2) * 256 + (e & 3)]; }
    float cm = fmaxf(fmaxf(fmaxf(t[0], t[1]), fmaxf(t[2], t[3])), fmaxf(fmaxf(t[4], t[5]), fmaxf(t[6], t[7])));
    if (first || __builtin_amdgcn_ballot_w64(cm > 8.0f) != 0ull) {
        cm = fmaxf(cm, __shfl_xor(cm, 16)); cm = fmaxf(cm, __shfl_xor(cm, 32));
        const float d = first ? cm : fmaxf(cm, 0.f), alpha = first ? 1.0f : __builtin_amdgcn_exp2f(-d);
        m += d; l *= alpha;
#pragma unroll
        for (int e = 0; e < 8; ++e) t[e] -= d;
#pragma unroll
        for (int db = 0; db < 4; ++db) O[db] *= alpha;
    }
    float ps = 0.f;
#pragma unroll
    for (int e = 0; e < 8; ++e) { t[e] = __builtin_amdgcn_exp2f(t[e]); ps += t[e]; }
    l += ps;
    union { u32x4 u; bf16x8 b; } pk;
    pk.u.x = cvt_pk_bf16(t[0], t[1]); pk.u.y = cvt_pk_bf16(t[2], t[3]); pk.u.z = cvt_pk_bf16(t[4], t[5]); pk.u.w = cvt_pk_bf16(t[6], t[7]);
#pragma unroll
    for (int db = 0; db < 4; ++db) O[db] = __builtin_amdgcn_mfma_f32_16x16x32_bf16(kv.v[db], pk.b, O[db], 0, 0, 0);
}
constexpr int ATT_RPB_OFF = 1024;
constexpr int ATT_MASK_OFF = 16384;
constexpr int ATT_Q_OFF = 28672;
__device__ __forceinline__ void attn_row(const bf16_t* U, const bf16_t* VT, bf16_t* YNA, LAS unsigned char* lds, int qtok0, int b, int r, int nloc, int h, int lane) {
    const int qi = lane & 15, kg = lane >> 4;
    LAS bf16x8* qs = (LAS bf16x8*)(lds + ATT_Q_OFF + h * 8192) + lane;
    { bf16x8 qv[8];
#pragma unroll
      for (int qb = 0; qb < 4; ++qb) { const bf16_t* qp = U + (size_t)(qtok0 + qb * 16 + qi) * UW + UQ + h * 64 + kg * 8; qv[qb * 2] = *(const bf16x8*)qp; qv[qb * 2 + 1] = *(const bf16x8*)(qp + 32); }
      __builtin_amdgcn_sched_barrier(0);
#pragma unroll
      for (int i = 0; i < 8; ++i) qs[i * 64] = qv[i]; }
    f32x4 O[4][4]; float m[4], l[4];
#pragma unroll
    for (int qb = 0; qb < 4; ++qb) { m[qb] = 0.f; l[qb] = 0.f;
#pragma unroll
        for (int db = 0; db < 4; ++db) O[qb][db] = (f32x4){0.f, 0.f, 0.f, 0.f}; }
    const int r0 = min(max(r - 4, 0), NROWS - 8);
    asm volatile("" : "+s"(nloc));
    const int nchunk = 8 + 2 * nloc, cbase = NLAT + b * CTXL, lbase = b * SEQ + r0 * GW;
    const LAS f32x4* mtab = (const LAS f32x4*)(lds + ATT_MASK_OFF) + lane;
    const LAS float* btab = (const LAS float*)(lds + ATT_RPB_OFF) + (kg * 8 - qi + 15);
#define ATT_TOKBASE(c) ((c) < 8 ? cbase + 32 * (c) : lbase + 32 * ((c) - 8))
    AttnKV A, B;
    const unsigned klo = (unsigned)((8 * (qi >> 2) + (qi & 3)) * UW + kg * 8), vlo = (unsigned)((qi >> 1) * 2 * MT + (qi & 1) * 32 + kg * 8);
    attn_load(A, U, VT, ATT_TOKBASE(0), h, klo, vlo);
    for (int c = 0; c < nchunk; c += 2) {
        attn_load(B, U, VT, ATT_TOKBASE(c + 1), h, klo, vlo);
        if (c < 8) {
#pragma unroll
            for (int qb = 0; qb < 4; ++qb) attn_step<false, 0>(A, qs[(qb * 2) * 64], qs[(qb * 2 + 1) * 64], O[qb], m[qb], l[qb], c == 0, btab, mtab);
        } else { const int bo = (h * 15 + (r0 + ((c - 8) >> 1) - r + 7)) * 31;
#pragma unroll
            for (int qb = 0; qb < 3; ++qb) attn_step<true, 0>(A, qs[(qb * 2) * 64], qs[(qb * 2 + 1) * 64], O[qb], m[qb], l[qb], false, btab + (bo - 16 * qb), mtab + qb * 128);
        }
        { const int cn = c + 2 < nchunk ? c + 2 : c; attn_load(A, U, VT, ATT_TOKBASE(cn), h, klo, vlo); }
        if (c < 8) {
#pragma unroll
            for (int qb = 0; qb < 4; ++qb) attn_step<false, 0>(B, qs[(qb * 2) * 64], qs[(qb * 2 + 1) * 64], O[qb], m[qb], l[qb], false, btab, mtab);
        } else { const int bo = (h * 15 + (r0 + ((c - 8) >> 1) - r + 7)) * 31;
#pragma unroll
            for (int qb = 1; qb < 4; ++qb) attn_step<true, 1>(B, qs[(qb * 2) * 64], qs[(qb * 2 + 1) * 64], O[qb], m[qb], l[qb], false, btab + (bo - 16 * qb), mtab + (3 + qb - 1) * 128);
        }
    }
#undef ATT_TOKBASE
#pragma unroll
    for (int qb = 0; qb < 4; ++qb) { float ls = l[qb]; ls += __shfl_xor(ls, 16); ls += __shfl_xor(ls, 32); const float inv = 1.0f / ls;
        bf16_t* yp = YNA + (size_t)(qtok0 + qb * 16 + qi) * 512 + h * 64 + kg * 4;
#pragma unroll
        for (int db = 0; db < 4; ++db) { u32x2 w; w.x = cvt_pk_bf16(O[qb][db][0] * inv, O[qb][db][1] * inv); w.y = cvt_pk_bf16(O[qb][db][2] * inv, O[qb][db][3] * inv); *(u32x2*)(yp + db * 16) = w; } }
}

__device__ __forceinline__ void lru_unit(KAp ap, int l, int tile, int hd, int dmask, LAS unsigned char* lds, int tid) {
    unsigned char* ws = ap->ws;
    const bf16_t* U = (const bf16_t*)(ws + WS_U);
    const int wave = __builtin_amdgcn_readfirstlane(tid >> 6), lane = tid & 63, n16 = lane & 15, kg = lane >> 4;
    LAS bf16_t* rxs = (LAS bf16_t*)(lds);
    LAS bf16_t* wl = (LAS bf16_t*)(lds + 36864);
    LAS float* cst = (LAS float*)(lds + 36864 + 18432);
    LAS float* wtot = (LAS float*)(lds + 36864 + 18432 + 1024);
    LAS unsigned* otile = (LAS unsigned*)(lds + 61440);
    const int pos0 = tile < 128 ? (tile & 7) * 256 : 0, seglen = tile < 128 ? SEQ : CTXL;
    __syncthreads();
    { const int c8 = (tid & 7) * 8, t0 = tid >> 3;
      const float* cw = ap->in[8] + (size_t)l * 4 * 256 + hd * 64 + c8; const float* cb = ap->in[9] + (size_t)l * 256 + hd * 64 + c8;
      u32x4 xv[4][4];
#pragma unroll
      for (int p = 0; p < 4; ++p)
#pragma unroll
          for (int k = 0; k < 4; ++k) { const int tt = t0 + 64 * p - 2 + k, pos = pos0 + tt; const bool in = pos >= 0 && pos < seglen;
              xv[p][k] = *(const u32x4*)(U + (size_t)(tile * 256 + (in ? tt : t0)) * UW + URX + hd * 64 + c8); }
      f32x4 wk[4][2], bv[2];
#pragma unroll
      for (int k = 0; k < 4; ++k) { wk[k][0] = *(const f32x4*)(cw + k * 256); wk[k][1] = *(const f32x4*)(cw + k * 256 + 4); }
      bv[0] = *(const f32x4*)cb; bv[1] = *(const f32x4*)(cb + 4);
      __builtin_amdgcn_sched_barrier(0);
#pragma unroll
      for (int p = 0; p < 4; ++p)
#pragma unroll
          for (int k = 0; k < 4; ++k) { const int pos = pos0 + t0 + 64 * p - 2 + k; if (!(pos >= 0 && pos < seglen)) xv[p][k] = (u32x4){0u, 0u, 0u, 0u}; }
#pragma unroll
      for (int p = 0; p < 4; ++p) { const int t = t0 + 64 * p; float acc[8] = {bv[0][0], bv[0][1], bv[0][2], bv[0][3], bv[1][0], bv[1][1], bv[1][2], bv[1][3]};
#pragma unroll
          for (int k = 0; k < 4; ++k) { const u32x4 v = xv[p][k]; const f32x4 w0 = wk[k][0], w1 = wk[k][1];
              acc[0] += w0[0] * bf_lo(v.x); acc[1] += w0[1] * bf_hi(v.x); acc[2] += w0[2] * bf_lo(v.y); acc[3] += w0[3] * bf_hi(v.y);
              acc[4] += w1[0] * bf_lo(v.z); acc[5] += w1[1] * bf_hi(v.z); acc[6] += w1[2] * bf_lo(v.w); acc[7] += w1[3] * bf_hi(v.w); }
          u32x4 o; o.x = cvt_pk_bf16(acc[0], acc[1]); o.y = cvt_pk_bf16(acc[2], acc[3]); o.z = cvt_pk_bf16(acc[4], acc[5]); o.w = cvt_pk_bf16(acc[6], acc[7]);
          *(LAS u32x4*)(rxs + t * 72 + c8) = o; } }
    for (int d = 0; d < 2; ++d) {
        if (!((dmask >> d) & 1)) continue;
        __syncthreads();
        { const bf16_t* rgw = (const bf16_t*)(ws + WS_RGW);
          u32x4 wv[2]; float c0 = 0.f, c1 = 0.f, lam = 0.f;
#pragma unroll
          for (int p = 0; p < 2; ++p) { const int item = tid + 512 * p, g = item >> 9, n = (item >> 3) & 63, c8 = (item & 7) * 8;
              wv[p] = *(const u32x4*)(rgw + (size_t)((((l * 2 + d) * 2 + g) * 4 + hd) * 64 + n) * 64 + c8); }
          if (tid < 64) { const int c = hd * 64 + tid; const float* rgb = ap->in[11];
              c0 = rgb[((l * 2 + d) * 2 + 0) * 256 + c]; c1 = rgb[((l * 2 + d) * 2 + 1) * 256 + c]; lam = ap->in[12][(l * 2 + d) * 256 + c]; }
          __builtin_amdgcn_sched_barrier(0);
#pragma unroll
          for (int p = 0; p < 2; ++p) { const int item = tid + 512 * p, g = item >> 9, n = (item >> 3) & 63, c8 = (item & 7) * 8; *(LAS u32x4*)(wl + (g * 64 + n) * 72 + c8) = wv[p]; }
          if (tid < 64) { cst[tid] = c0; cst[64 + tid] = c1; const float z = -lam; cst[128 + tid] = fmaxf(z, 0.f) + log1pf(__expf(-fabsf(z))); } }
        __syncthreads();
        f32x4 A_[2][4], H_[2][4];
        {
            bf16x8 af[2][2];
#pragma unroll
            for (int mb = 0; mb < 2; ++mb)
#pragma unroll
                for (int kc = 0; kc < 2; ++kc) af[mb][kc] = *(const LAS bf16x8*)(rxs + (wave * 32 + mb * 16 + n16) * 72 + kc * 32 + kg * 8);
#pragma unroll
            for (int nb = 0; nb < 4; ++nb) {
                f32x4 pr[2][2];
#pragma unroll
                for (int g = 0; g < 2; ++g) {
                    const bf16x8 b0 = *(const LAS bf16x8*)(wl + (g * 64 + nb * 16 + n16) * 72 + kg * 8), b1 = *(const LAS bf16x8*)(wl + (g * 64 + nb * 16 + n16) * 72 + 32 + kg * 8);
#pragma unroll
                    for (int mb = 0; mb < 2; ++mb) { f32x4 z = (f32x4){0.f, 0.f, 0.f, 0.f};
                        z = __builtin_amdgcn_mfma_f32_16x16x32_bf16(af[mb][0], b0, z, 0, 0, 0);
                        pr[g][mb] = __builtin_amdgcn_mfma_f32_16x16x32_bf16(af[mb][1], b1, z, 0, 0, 0); }
                }
                const int c = nb * 16 + n16; const float br = cst[c], bi = cst[64 + c], sp = cst[128 + c];
#pragma unroll
                for (int mb = 0; mb < 2; ++mb)
#pragma unroll
                    for (int e = 0; e < 4; ++e) { const int tok = wave * 32 + mb * 16 + kg * 4 + e; const float xr = bf2f(rxs[tok * 72 + c]);
                        const float rg = sigmoidf_(pr[0][mb][e] + br), ig = sigmoidf_(pr[1][mb][e] + bi);
                        const float la = -8.0f * rg * sp; const float av = __expf(la);
                        A_[mb][nb][e] = av; H_[mb][nb][e] = __builtin_amdgcn_sqrtf(fmaxf(1.0f - av * av, 0.f)) * (ig * xr); }
            }
        }
        const bool rev = d != 0;
#pragma unroll
        for (int nb = 0; nb < 4; ++nb) {
            float tA[2], tH[2];
#pragma unroll
            for (int mb = 0; mb < 2; ++mb) {
                f32x4 av = A_[mb][nb], bv = H_[mb][nb]; f32x4 cA, cH;
                if (!rev) { cA[0] = av[0]; cH[0] = bv[0];
#pragma unroll
                    for (int e = 1; e < 4; ++e) { cH[e] = av[e] * cH[e - 1] + bv[e]; cA[e] = cA[e - 1] * av[e]; } }
                else { cA[3] = av[3]; cH[3] = bv[3];
#pragma unroll
                    for (int e = 2; e >= 0; --e) { cH[e] = av[e] * cH[e + 1] + bv[e]; cA[e] = cA[e + 1] * av[e]; } }
                float gA = rev ? cA[0] : cA[3], gH = rev ? cH[0] : cH[3];
                { const float pA = __shfl(gA, rev ? lane + 16 : lane - 16), pH = __shfl(gH, rev ? lane + 16 : lane - 16);
                  const bool use = rev ? (kg <= 2) : (kg >= 1); if (use) { gH = gA * pH + gH; gA = pA * gA; } }
                { const float pA = __shfl(gA, rev ? lane + 32 : lane - 32), pH = __shfl(gH, rev ? lane + 32 : lane - 32);
                  const bool use = rev ? (kg <= 1) : (kg >= 2); if (use) { gH = gA * pH + gH; gA = pA * gA; } }
                float xA = __shfl(gA, rev ? lane + 16 : lane - 16), xH = __shfl(gH, rev ? lane + 16 : lane - 16);
                const bool first = rev ? (kg == 3) : (kg == 0); if (first) { xA = 1.f; xH = 0.f; }
#pragma unroll
                for (int e = 0; e < 4; ++e) { cH[e] = cA[e] * xH + cH[e]; cA[e] = cA[e] * xA; }
                tA[mb] = __shfl(gA, rev ? n16 : n16 + 48); tH[mb] = __shfl(gH, rev ? n16 : n16 + 48);
                A_[mb][nb] = cA; H_[mb][nb] = cH;
            }
            const float pA = rev ? tA[1] : tA[0], pH = rev ? tH[1] : tH[0];
#pragma unroll
            for (int e = 0; e < 4; ++e) { const float a0 = A_[0][nb][e], h0 = H_[0][nb][e], a1 = A_[1][nb][e], h1 = H_[1][nb][e];
                H_[0][nb][e] = rev ? a0 * pH + h0 : h0; A_[0][nb][e] = rev ? a0 * pA : a0;
                H_[1][nb][e] = rev ? h1 : a1 * pH + h1; A_[1][nb][e] = rev ? a1 : a1 * pA; }
            const float wA = tA[0] * tA[1], wH = rev ? (tA[0] * tH[1] + tH[0]) : (tA[1] * tH[0] + tH[1]);
            if (kg == 0) { wtot[(wave * 64 + nb * 16 + n16) * 2] = wA; wtot[(wave * 64 + nb * 16 + n16) * 2 + 1] = wH; }
        }
        __syncthreads();
        bf16_t* hloc = (bf16_t*)(ws + WS_HLOC) + (size_t)d * MT * 256; bf16_t* cuma = (bf16_t*)(ws + WS_CUMA) + (size_t)d * MT * 256;
        float* tcar = (float*)(ws + WS_TCAR) + ((size_t)(d * 144 + tile) * 256 + hd * 64) * 2;
#pragma unroll
        for (int nb = 0; nb < 4; ++nb) { const int c = nb * 16 + n16;
            float xA = 1.f, xH = 0.f;
            if (!rev) { for (int w = 0; w < wave; ++w) { const float wa = wtot[(w * 64 + c) * 2], wh = wtot[(w * 64 + c) * 2 + 1]; xH = wa * xH + wh; xA = xA * wa; } }
            else { for (int w = 7; w > wave; --w) { const float wa = wtot[(w * 64 + c) * 2], wh = wtot[(w * 64 + c) * 2 + 1]; xH = wa * xH + wh; xA = xA * wa; } }
#pragma unroll
            for (int mb = 0; mb < 2; ++mb)
#pragma unroll
                for (int e = 0; e < 4; ++e) { const float hv = A_[mb][nb][e] * xH + H_[mb][nb][e], cv = A_[mb][nb][e] * xA;
                    otile[(wave * 32 + mb * 16 + kg * 4 + e) * 68 + c] = cvt_pk_bf16(hv, cv); }
            if (wave == (rev ? 0 : 7) && kg == 0) { const float wa = wtot[(wave * 64 + c) * 2], wh = wtot[(wave * 64 + c) * 2 + 1];
                tcar[c * 2] = xA * wa; tcar[c * 2 + 1] = wa * xH + wh; }
        }
        __syncthreads();
#pragma unroll
        for (int p = 0; p < 4; ++p) { const int item = tid + 512 * p, t = item >> 3, c8 = (item & 7) * 8;
            const u32x4 w0 = *(const LAS u32x4*)(otile + t * 68 + c8), w1 = *(const LAS u32x4*)(otile + t * 68 + c8 + 4);
            u32x4 ho, co;
            ho.x = (w0.x & 0xffffu) | (w0.y << 16); ho.y = (w0.z & 0xffffu) | (w0.w << 16); ho.z = (w1.x & 0xffffu) | (w1.y << 16); ho.w = (w1.z & 0xffffu) | (w1.w << 16);
            co.x = (w0.x >> 16) | (w0.y & 0xffff0000u); co.y = (w0.z >> 16) | (w0.w & 0xffff0000u); co.z = (w1.x >> 16) | (w1.y & 0xffff0000u); co.w = (w1.z >> 16) | (w1.w & 0xffff0000u);
            const size_t o = ((size_t)tile * 256 + t) * 256 + hd * 64 + c8;
            *(u32x4*)(hloc + o) = ho; *(u32x4*)(cuma + o) = co; }
    }
}

__device__ __forceinline__ void mixer_phase(KAp ap, int l, LAS unsigned char* lds, int tid, int G, int blk) {
    unsigned char* ws = ap->ws;
    const int wave = __builtin_amdgcn_readfirstlane(tid >> 6), lane = tid & 63;
    { LAS float* rpb = (LAS float*)(lds + ATT_RPB_OFF); const float* rp = ap->in[13] + (size_t)l * 3720;
      { float rv[8];
#pragma unroll
        for (int p = 0; p < 8; ++p) { const int i = tid + 512 * p; rv[p] = rp[i < 3720 ? i : 3719]; }
        __builtin_amdgcn_sched_barrier(0);
#pragma unroll
        for (int p = 0; p < 8; ++p) { const int i = tid + 512 * p; if (i < 3720) rpb[i] = rv[p] * LOG2E; } }
      LAS float* mt = (LAS float*)(lds + ATT_MASK_OFF);
      for (int i = tid; i < 6 * 2 * 64 * 4; i += 512) { const int e4 = i & 3, ln = (i >> 2) & 63, part = (i >> 8) & 1, cfg = i >> 9, half = cfg / 3, qb = cfg - 3 * half + half;
          const int kcol = half * 32 + (ln >> 4) * 8 + part * 4 + e4, qcol = qb * 16 + (ln & 15), cs = min(max(qcol - 8, 0), GW - 16);
          mt[i] = (kcol >= cs && kcol < cs + 16) ? 0.f : -3.0e38f; } }
    __syncthreads();
    const bf16_t* U = (const bf16_t*)(ws + WS_U); const bf16_t* VT = (const bf16_t*)(ws + WS_VT); bf16_t* YNA = (bf16_t*)(ws + WS_YNA);
    for (int rep = 0; rep < 1 + ((REPMASK >> 12) & 1); ++rep)
    {
        const int nun = NBATCH * NROWS + (l == 0 ? NBATCH * 4 : 0);
        for (int i = 0; i * G < nun + G; ++i) {
            int un;
            if (G == 256) { const int xcd = blk & 7, jj = blk >> 3;
                if (i < 2) un = ((2 * xcd + i) << 5) + jj; else if (i == 2 && l == 0 && jj < 8) un = NBATCH * NROWS + (2 * xcd + (jj >> 2)) * 4 + (jj & 3); else un = -1; }
            else un = (i * G + blk < nun) ? i * G + blk : -1;
            if (un < 0) continue;
            if (un < NBATCH * NROWS) { const int b = un >> 5, r = un & 31; attn_row(U, VT, YNA, lds, b * SEQ + r * GW, b, r, 8, wave, lane); }
            else { const int q = un - NBATCH * NROWS, b = q >> 2; attn_row(U, VT, YNA, lds, NLAT + b * CTXL + (q & 3) * 64, b, 0, 0, wave, lane); }
        }
    }
#ifndef NO_LRU
    int tid2 = tid; asm volatile("" : "+v"(tid2));
    for (int rep = 0; rep < 1 + ((REPMASK >> 13) & 1); ++rep) {
        if (G == 256) {
            for (int un = blk; un < 512; un += G) lru_unit(ap, l, un >> 2, un & 3, 3, lds, tid2);
            if (blk >= 64 && blk < 192) { const int hu = blk - 64, un = 512 + (hu >> 1); lru_unit(ap, l, un >> 2, un & 3, 1 << (hu & 1), lds, tid2); }
        } else for (int un = blk; un < 144 * 4; un += G) lru_unit(ap, l, un >> 2, un & 3, 3, lds, tid2);
    }
#endif
}

struct MRow { u32x4 y; u32x2 hf, cf, hb, cb, rg, sb, cx[3]; int inm; };
__device__ __forceinline__ void merge_load(MRow& R, const bf16_t* U, const bf16_t* YNA, const bf16_t* hloc, const bf16_t* cuma, int row, int pos, int seglen, int lane) {
    const int c = lane * 4;
    R.y = *(const u32x4*)(YNA + (size_t)row * 512 + lane * 8);
    R.hf = *(const u32x2*)(hloc + (size_t)row * 256 + c); R.cf = *(const u32x2*)(cuma + (size_t)row * 256 + c);
    R.hb = *(const u32x2*)(hloc + (size_t)(MT + row) * 256 + c); R.cb = *(const u32x2*)(cuma + (size_t)(MT + row) * 256 + c);
    const bf16_t* up = U + (size_t)row * UW;
    R.rg = *(const u32x2*)(up + URG + c); R.sb = *(const u32x2*)(up + USB + c);
    R.inm = 0;
#pragma unroll
    for (int k = 0; k < 3; ++k) { const int pp = pos - 1 + k; const bool in = pp >= 0 && pp < seglen; const bf16_t* rp = up + (ptrdiff_t)(in ? k - 1 : 0) * UW;
        R.cx[k] = *(const u32x2*)(rp + UCX + c); R.inm |= in ? (1 << k) : 0; }
}
struct MWts { f32x4 g0, g1, gb, gc, bias, w[3]; };
__device__ __forceinline__ void merge_compute(const MRow& R, bf16_t* MG, const MWts& W, const LAS float* car, int row, int lane) {
    { const u32x4 v = R.y; float f[8] = {bf_lo(v.x), bf_hi(v.x), bf_lo(v.y), bf_hi(v.y), bf_lo(v.z), bf_hi(v.z), bf_lo(v.w), bf_hi(v.w)};
      float ss = 0.f;
#pragma unroll
      for (int j = 0; j < 8; ++j) ss += f[j] * f[j];
      ss = wave_sum(ss); const float rs = rsqrtf(ss * (1.0f / 512.0f) + EPSN);
      const f32x4 g0 = W.g0, g1 = W.g1;
      u32x4 o; o.x = cvt_pk_bf16(f[0] * rs * g0[0], f[1] * rs * g0[1]); o.y = cvt_pk_bf16(f[2] * rs * g0[2], f[3] * rs * g0[3]);
      o.z = cvt_pk_bf16(f[4] * rs * g1[0], f[5] * rs * g1[1]); o.w = cvt_pk_bf16(f[6] * rs * g1[2], f[7] * rs * g1[3]);
      *(u32x4*)(MG + (size_t)row * D + lane * 8) = o; }
    const int c = lane * 4;
    { const f32x4 kf = *(const LAS f32x4*)(car + c), kb = *(const LAS f32x4*)(car + 256 + c);
      float y[4];
      y[0] = (bf_lo(R.hf.x) + bf_lo(R.cf.x) * kf[0] + bf_lo(R.hb.x) + bf_lo(R.cb.x) * kb[0]) * gelu_tanh(bf_lo(R.rg.x));
      y[1] = (bf_hi(R.hf.x) + bf_hi(R.cf.x) * kf[1] + bf_hi(R.hb.x) + bf_hi(R.cb.x) * kb[1]) * gelu_tanh(bf_hi(R.rg.x));
      y[2] = (bf_lo(R.hf.y) + bf_lo(R.cf.y) * kf[2] + bf_lo(R.hb.y) + bf_lo(R.cb.y) * kb[2]) * gelu_tanh(bf_lo(R.rg.y));
      y[3] = (bf_hi(R.hf.y) + bf_hi(R.cf.y) * kf[3] + bf_hi(R.hb.y) + bf_hi(R.cb.y) * kb[3]) * gelu_tanh(bf_hi(R.rg.y));
      float ss = y[0] * y[0] + y[1] * y[1] + y[2] * y[2] + y[3] * y[3]; ss = wave_sum(ss); const float rs = rsqrtf(ss * (1.0f / 256.0f) + EPSN);
      const f32x4 g0 = W.gb;
      u32x2 o; o.x = cvt_pk_bf16(y[0] * rs * g0[0], y[1] * rs * g0[1]); o.y = cvt_pk_bf16(y[2] * rs * g0[2], y[3] * rs * g0[3]);
      *(u32x2*)(MG + (size_t)row * D + 512 + c) = o; }
    { const f32x4 bias = W.bias; float cv[4] = {bias[0], bias[1], bias[2], bias[3]};
#pragma unroll
      for (int k = 0; k < 3; ++k) { u32x2 cx = R.cx[k]; if (!((R.inm >> k) & 1)) cx = (u32x2){0u, 0u}; const f32x4 w = W.w[k];
          cv[0] += w[0] * bf_lo(cx.x); cv[1] += w[1] * bf_hi(cx.x); cv[2] += w[2] * bf_lo(cx.y); cv[3] += w[3] * bf_hi(cx.y); }
      const u32x2 sb = R.sb;
      float y[4] = {bf_lo(sb.x) * cv[0], bf_hi(sb.x) * cv[1], bf_lo(sb.y) * cv[2], bf_hi(sb.y) * cv[3]};
      float ss = y[0] * y[0] + y[1] * y[1] + y[2] * y[2] + y[3] * y[3]; ss = wave_sum(ss); const float rs = rsqrtf(ss * (1.0f / 256.0f) + EPSN);
      const f32x4 g0 = W.gc;
      u32x2 o; o.x = cvt_pk_bf16(y[0] * rs * g0[0], y[1] * rs * g0[1]); o.y = cvt_pk_bf16(y[2] * rs * g0[2], y[3] * rs * g0[3]);
      *(u32x2*)(MG + (size_t)row * D + 768 + c) = o; }
}
__device__ __forceinline__ void merge_phase(KAp ap, int l, int ntok, LAS unsigned char* lds, int tid, int G, int blk) {
    unsigned char* ws = ap->ws;
    const int wave = __builtin_amdgcn_readfirstlane(tid >> 6), lane = tid & 63;
    const bf16_t* U = (const bf16_t*)(ws + WS_U); const bf16_t* YNA = (const bf16_t*)(ws + WS_YNA);
    const bf16_t* hloc = (const bf16_t*)(ws + WS_HLOC); const bf16_t* cuma = (const bf16_t*)(ws + WS_CUMA); const float* tcar = (const float*)(ws + WS_TCAR);
    bf16_t* MG = (bf16_t*)(ws + WS_H);
    const float* og = ap->in[16] + (size_t)l * D;
    const float* scw = ap->in[14] + (size_t)l * 3 * 256; const float* scb = ap->in[15] + (size_t)l * 256;
    LAS float* car = (LAS float*)lds;
    MWts W; { const int c = lane * 4; W.g0 = *(const f32x4*)(og + lane * 8); W.g1 = *(const f32x4*)(og + lane * 8 + 4); W.gb = *(const f32x4*)(og + 512 + c); W.gc = *(const f32x4*)(og + 768 + c);
        W.bias = *(const f32x4*)(scb + c); W.w[0] = *(const f32x4*)(scw + c); W.w[1] = *(const f32x4*)(scw + 256 + c); W.w[2] = *(const f32x4*)(scw + 512 + c); }
    const int chunk = (ntok + G - 1) / G, c0 = blk * chunk, c1 = (c0 + chunk < ntok) ? c0 + chunk : ntok;
    for (int ts = c0; ts < c1; ) {
        const int tile = ts >> 8, te = ((tile + 1) << 8) < c1 ? ((tile + 1) << 8) : c1;
        __syncthreads();
        { const int d = tid >> 8, c = tid & 255; float hst = 0.f;
          if (tile < 128) { const int bb = tile >> 3; const float* tc = tcar + (size_t)d * 144 * 512 + c * 2;
              float pa[8], ph[8]; const int n = d == 0 ? (tile - bb * 8) : (bb * 8 + 7 - tile);
              hst = tc[(size_t)(128 + bb) * 512 + 1];
#pragma unroll
              for (int i = 0; i < 7; ++i) { const int tt = d == 0 ? bb * 8 + i : bb * 8 + 7 - i; const bool on = i < n; pa[i] = on ? tc[(size_t)tt * 512] : 1.f; ph[i] = on ? tc[(size_t)tt * 512 + 1] : 0.f; }
#pragma unroll
              for (int i = 0; i < 7; ++i) hst = pa[i] * hst + ph[i]; }
          car[tid] = hst; }
        __syncthreads();
        const int seglen = tile < 128 ? SEQ : CTXL, pmask = tile < 128 ? 2047 : 255;
        MRow cur, nxt; int row = ts + wave;
        if (row < te) merge_load(cur, U, YNA, hloc, cuma, row, row & pmask, seglen, lane);
        for (; row < te; row += 8) {
            { const int rn = row + 8 < te ? row + 8 : te - 1; merge_load(nxt, U, YNA, hloc, cuma, rn, rn & pmask, seglen, lane); }
            merge_compute(cur, MG, W, car, row, lane);
            cur = nxt;
        }
        ts = te;
    }
}

constexpr int NPHASE = 20;
#ifndef PH_ATTR
#define PH_ATTR __device__ __forceinline__
#endif
PH_ATTR void ph_p0(int wv, LAS unsigned char* lds) { p0_phase(ka_get(), lds, op_tid(), op_grid(), op_blk()); }
constexpr size_t WS_XTAIL = WS_U + (size_t)MPERM * 1024 * 2;
static_assert(WS_XTAIL + (size_t)NLAT * 1024 * 2 <= WS_C, "bf16 stream tail fits behind HP / Y2 in region U");
PH_ATTR void ph_norm1(int wv, int l, LAS unsigned char* lds) { KAp ka = ka_get(); unsigned char* ws = ka->ws;
    const float* mod = (const float*)(ws + WS_MOD);
    RnArgs A{}; A.gvec = ka->in[6] + (size_t)l * D; A.modl = mod + (size_t)l * 17 * NMODC; A.si = 0; A.H = (bf16_t*)(ws + WS_H); A.ntok = MT;
    if (l == 0) { A.xl = ka->in[0]; A.xc = ka->in[2]; resnorm_phase<0, false, false, false>(A, lds, op_tid(), op_grid(), op_blk()); }
    else { A.xs16 = (const bf16_t*)ka->out; A.xd16 = (bf16_t*)ka->out; A.Y = (const bf16_t*)(ws + WS_U); A.gatev = mod; A.gi = 5;
        A.tokinfo_prev = (const u32x4*)(ws + WS_TOKINFO); A.gcnt_prev = (const unsigned*)(ws + WS_CTL) + CW_CNT;
        resnorm_phase<2, false, false, true>(A, lds, op_tid(), op_grid(), op_blk()); } }
PH_ATTR void ph_inproj(int wv, int l, LAS unsigned char* lds) { KAp ka = ka_get(); unsigned char* ws = ka->ws;
    SchedInproj S{op_grid(), op_blk(), 144, (const char*)(ws + WS_H), (const char*)(ws + WS_WIN) + (size_t)l * 2816 * 2048, l == 1};
    EpiInproj E{(bf16_t*)(ws + WS_U), (bf16_t*)(ws + WS_VT)};
    pg8::gemm_phase<EpiInproj, SchedInproj>(wv, lds, 1024, 1024, 1024, S, E);
    const int blk_ = op_blk(); const bool helper = op_grid() != 256 || blk_ >= (l == 0 ? 48 : 208);
    if (helper) { if (l == 0) { convert_queue(ka, lds, CQ0, CQ1, 0, op_tid()); gu8_queue(ka, lds, 0, NGU8_LAYER, 5, op_tid()); }
                  } }
PH_ATTR void ph_mixer(int wv, int l, LAS unsigned char* lds) { KAp ka = ka_get(); mixer_phase(ka, l, lds, op_tid(), op_grid(), op_blk());
    if (l == 1) { __syncthreads(); gu8_queue(ka, lds, CH2, 2 * NGU8_LAYER, 8, op_tid()); gu8_queue<true>(ka, lds, NGD8_LAYER, 2 * NGD8_LAYER, 10, op_tid()); } }
PH_ATTR void ph_merge(int wv, int l, LAS unsigned char* lds) { merge_phase(ka_get(), l, (l == 0 ? 144 : 128) * 256, lds, op_tid(), op_grid(), op_blk()); }
PH_ATTR void ph_outproj(int wv, int l, LAS unsigned char* lds) { KAp ka = ka_get(); unsigned char* ws = ka->ws;
    SchedOut S{op_grid(), op_blk(), l == 0 ? 144 : 128, (const char*)(ws + WS_H), (const char*)(ws + WS_WOUT) + (size_t)l * 1024 * 2048};
    EpiStore E{(bf16_t*)(ws + WS_C)};
    pg8::gemm_phase<EpiStore, SchedOut>(wv, lds, 1024, 1024, 1024, S, E);
    if (l == 0 && (op_grid() != 256 || op_blk() >= 64)) { gu8_queue<true>(ka, lds, 0, NGD8_LAYER, 9, op_tid()); convert_queue(ka, lds, CQ1, CQ2, 1, op_tid()); gu8_queue(ka, lds, NGU8_LAYER, CH1, 6, op_tid()); } }
PH_ATTR void ph_norm2(int wv, int l, LAS unsigned char* lds, int dummy = 0) { KAp ka = ka_get(); unsigned char* ws = ka->ws;
    const float* mod = (const float*)(ws + WS_MOD);
    RnArgs A{}; A.Y = (const bf16_t*)(ws + WS_C); A.gatev = mod + (size_t)l * 17 * NMODC; A.gi = 2;
    A.gvec = ka->in[18] + (size_t)l * D; A.modl = mod + (size_t)l * 17 * NMODC; A.si = 3; A.H8 = ws + WS_H; A.HS = (float*)(ws + WS_HS); A.rw = (f32x4*)(ws + WS_U) + (dummy ? (size_t)NBUCK * MT : 0); A.ntok = (l == 0 ? 144 : 128) * 256;
    A.wrt = ka->in[19]; A.brt = ka->in[20]; A.gcnt = (unsigned*)(ws + WS_CTL) + CW_CNT + l * 64 + (dummy ? 1024 : 0); A.tokinfo = dummy ? (u32x4*)(ws + WS_TCAR) : (u32x4*)(ws + WS_TOKINFO);
    if (l == 0) { A.xl = ka->in[0]; A.xc = ka->in[2]; A.xd16 = (bf16_t*)ka->out; resnorm_phase<1, true, false, false>(A, lds, op_tid(), op_grid(), op_blk()); }
    else { A.xs16 = (const bf16_t*)ka->out; A.xd16 = (bf16_t*)(ws + WS_XTAIL); resnorm_phase<1, true, false, true>(A, lds, op_tid(), op_grid(), op_blk()); } }
PH_ATTR void ph_permute(int wv, int l, LAS unsigned char* lds) { KAp ka = ka_get(); unsigned char* ws = ka->ws;
    permute_phase(ws + WS_H, (const float*)(ws + WS_HS), ws + WS_U, (const u32x4*)(ws + WS_TOKINFO), (const unsigned*)(ws + WS_CTL) + CW_CNT + l * 64,
                  (f32x4*)(ws + WS_ROWW), (l == 0 ? 144 : 128) * 256, (LAS int*)(lds + LDS_MISC + 256), op_tid(), op_grid(), op_blk()); }
PH_ATTR void ph_gateup(int wv, int l, LAS unsigned char* lds) { KAp ka = ka_get(); unsigned char* ws = ka->ws; LAS int* tst = (LAS int*)(lds + LDS_MISC + 256);
    __syncthreads(); moe_offsets((const unsigned*)(ws + WS_CTL) + CW_CNT + l * 64, tst, op_tid());
    SchedMoe S{op_grid(), op_blk(), 8, tst[NBUCK], tst, (const char*)(ws + WS_H), (const char*)(ws + WS_WGU) + (size_t)l * 16 * 1024 * 1024, 0, (const f32x4*)(ws + WS_U)};
    EpiGateUp E{ws + WS_C, (const f32x4*)(ws + WS_U), (const float*)(ws + WS_SGU) + (size_t)l * 16 * 1024, (const float*)(ws + WS_TD) + (size_t)l * 16 * 512};
    pg8::gemm_phase<EpiGateUp, SchedMoe, GU_FP8_MMA, true>(wv, lds, 512, 512, 512, S, E);
    if (l == 0) gu8_queue(ka, lds, CH1, CH2, 7, op_tid()); }
PH_ATTR void ph_down(int wv, int l, LAS unsigned char* lds) { KAp ka = ka_get(); unsigned char* ws = ka->ws; LAS int* tst = (LAS int*)(lds + LDS_MISC + 256);
    __syncthreads(); moe_offsets((const unsigned*)(ws + WS_CTL) + CW_CNT + l * 64, tst, op_tid());
    SchedMoe S{op_grid(), op_blk(), 4, tst[NBUCK], tst, (const char*)(ws + WS_C), (const char*)(ws + WS_WD) + (size_t)l * 16 * 1024 * 512, 1, nullptr};
    EpiStoreS E{(bf16_t*)(ws + WS_U), 1.0f / (HID_CH * FP8_TOP)};
    pg8::gemm_phase<EpiStoreS, SchedMoe, true>(wv, lds, 512, 512, 256, S, E);
 }
PH_ATTR void ph_final(int wv, LAS unsigned char* lds) { KAp ka = ka_get(); unsigned char* ws = ka->ws;
    RnArgs A{}; A.xs16 = (const bf16_t*)(ws + WS_XTAIL); A.Y = (const bf16_t*)(ws + WS_U); A.gatev = (const float*)(ws + WS_MOD) + (size_t)17 * NMODC; A.gi = 5;
    A.tokinfo_prev = (const u32x4*)(ws + WS_TOKINFO); A.gcnt_prev = (const unsigned*)(ws + WS_CTL) + CW_CNT + 64;
    A.gvec = ka->in[24]; A.outf = ka->out; A.ntok = NLAT;
    resnorm_phase<2, false, true, true>(A, lds, op_tid(), op_grid(), op_blk()); }

__global__ void __launch_bounds__(512, 2) mk_fwd(KArgs args) {
    extern __shared__ __attribute__((aligned(16))) unsigned char lds_raw[];
    LAS unsigned char* lds = (LAS unsigned char*)lds_raw;
    const int wv = __builtin_amdgcn_readfirstlane((int)threadIdx.x >> 6);
    volatile LAS unsigned* misc = (volatile LAS unsigned*)(lds + LDS_MISC);
    if (wv == 0) misc[lane_id_()] = 0u;
    __syncthreads();
    const int lo = args.ph_lo, hi = args.ph_hi;
    XcdBarrier bar; bar.bar = (unsigned*)(args.ws + WS_CTL) + CW_BAR; bar.x = 0; bar.st = misc;
    if (hi - lo > 1) bar = xcd_barrier_post((unsigned*)(args.ws + WS_CTL) + CW_BAR, misc, wv * 64 + lane_id_());
#ifndef PHMASK
#define PHMASK 0x7ff
#endif
#define IN(k) (((PHMASK >> ((k) == 0 ? 0 : ((k) == 19 ? 10 : 1 + ((k) - 1) % 9))) & 1) && lo <= (k) && (k) < hi)
#define SEAM(k) do { if (IN(k) && IN((k) + 1)) xcd_barrier(bar, op_tid()); } while (0)
#define REP(kind) ((REPMASK >> (kind)) & 1)
    if (IN(0)) { ph_p0(wv, lds); if (REP(0)) { __syncthreads(); ph_p0(wv, lds); } }
    SEAM(0);
#pragma nounroll
    for (int l = 0; l < 2; ++l) {
        const int pb = 1 + 9 * l;
        if (IN(pb + 0)) { ph_norm1(wv, l, lds); if (REP(1) && l == 0) { __syncthreads(); ph_norm1(wv, l, lds); } }
        SEAM(pb + 0);
        if (IN(pb + 1)) { ph_inproj(wv, l, lds); if (REP(2)) { __syncthreads(); ph_inproj(wv, l, lds); } }
        SEAM(pb + 1);
        if (IN(pb + 2)) { ph_mixer(wv, l, lds); if (REP(3)) { __syncthreads(); ph_mixer(wv, l, lds); } }
        SEAM(pb + 2);
        if (IN(pb + 3)) { ph_merge(wv, l, lds); if (REP(4)) { __syncthreads(); ph_merge(wv, l, lds); } }
        SEAM(pb + 3);
        if (IN(pb + 4)) { ph_outproj(wv, l, lds); if (REP(5)) { __syncthreads(); ph_outproj(wv, l, lds); } }
        SEAM(pb + 4);
        if (IN(pb + 5)) { if (REP(6)) { ph_norm2(wv, l, lds, 1); __syncthreads(); } ph_norm2(wv, l, lds); }
        SEAM(pb + 5);
        if (IN(pb + 7)) { ph_gateup(wv, l, lds); if (REP(8)) { __syncthreads(); ph_gateup(wv, l, lds); } }
        SEAM(pb + 7);
        if (IN(pb + 8)) { ph_down(wv, l, lds); if (REP(9)) { __syncthreads(); ph_down(wv, l, lds); } }
        SEAM(pb + 8);
    }
    if (IN(19)) { ph_final(wv, lds); if (REP(10)) { __syncthreads(); ph_final(wv, lds); } }
#undef IN
#undef SEAM
}

extern "C" void kernel_launch(void* const* d_in, const int* in_sizes, int n_in, void* d_out, int out_size, void* d_ws, size_t ws_size, hipStream_t stream) {
    static int grid = 0;
    if (grid == 0) {
        if (n_in != 25 || out_size != NLAT * D || ws_size < WS_END) { fprintf(stderr, "kernel_launch: unexpected shapes (n_in %d out %d ws %zu need %zu)\n", n_in, out_size, ws_size, (size_t)WS_END); grid = -1; return; }
        int dev = 0, cus = 0, per_cu = 0;
        if (hipGetDevice(&dev) != hipSuccess || hipDeviceGetAttribute(&cus, hipDeviceAttributeMultiprocessorCount, dev) != hipSuccess) { grid = -1; return; }
        if (hipFuncSetAttribute((const void*)mk_fwd, hipFuncAttributeMaxDynamicSharedMemorySize, LDS_BYTES) != hipSuccess) { fprintf(stderr, "kernel_launch: hipFuncSetAttribute failed\n"); grid = -1; return; }
        if (hipOccupancyMaxActiveBlocksPerMultiprocessor(&per_cu, (const void*)mk_fwd, 512, LDS_BYTES) != hipSuccess || per_cu < 1) { fprintf(stderr, "kernel_launch: occupancy query says %d\n", per_cu); (void)hipGetLastError(); grid = -1; return; }
        grid = cus;
        if (grid != 256) { fprintf(stderr, "kernel_launch: built for 256 CUs, got %d\n", cus); grid = -1; return; }
    }
    if (grid < 0) return;
    (void)hipMemsetAsync((char*)d_ws + WS_CTL, 0, CTL_BYTES, stream);
    KArgs a{};
    for (int i = 0; i < 25; ++i) a.in[i] = (const float*)d_in[i];
    a.out = (float*)d_out; a.ws = (unsigned char*)d_ws;
#if MK_PER_PHASE
    for (int p = 0; p < NPHASE; ++p) { a.ph_lo = p; a.ph_hi = p + 1; hipLaunchKernelGGL(mk_fwd, dim3(grid), dim3(512), LDS_BYTES, stream, a); }
#else
    a.ph_lo = 0; a.ph_hi = NPHASE;
    hipLaunchKernelGGL(mk_fwd, dim3(grid), dim3(512), LDS_BYTES, stream, a);
#endif
}
```

```cpp
#include <hip/hip_runtime.h>
#include <cstdio>
#include <cstdint>

#ifndef MK_PER_PHASE
#define MK_PER_PHASE 0
#endif

#ifndef REPMASK
#define REPMASK 0
#endif
#define LAS __attribute__((address_space(3)))
#ifndef GU_FP8_MMA
#define GU_FP8_MMA true
#endif
typedef unsigned short bf16_t;
typedef short bf16x8 __attribute__((ext_vector_type(8)));
typedef float f32x4 __attribute__((ext_vector_type(4)));
typedef float f32x2 __attribute__((ext_vector_type(2)));
typedef unsigned u32x4 __attribute__((ext_vector_type(4)));
typedef unsigned u32x2 __attribute__((ext_vector_type(2)));
typedef int i32x8 __attribute__((ext_vector_type(8)));
typedef int i32x4 __attribute__((ext_vector_type(4)));

constexpr int D = 1024, NBATCH = 16, SEQ = 2048, CTXL = 256, GW = 64, NROWS = 32;
constexpr int NLAT = NBATCH * SEQ;
constexpr int NCTX = NBATCH * CTXL;
constexpr int MT = NLAT + NCTX;
constexpr int NMODC = 6 * D;
constexpr int UW = 2080;
constexpr int UQ = 0, UK = 512, URX = 1024, URG = 1280, USB = 1536, UCX = 1792;
constexpr int NBUCK = 24;
constexpr int MPERM = MT + NBUCK * 256;
constexpr float EPSN = 1e-6f;
constexpr float LOG2E = 1.4426950408889634f;

constexpr size_t al256(size_t x) { return (x + 255) & ~(size_t)255; }
constexpr size_t CTL_BYTES = 65536;
constexpr size_t WS_CTL = 0;
constexpr size_t WS_MOD = WS_CTL + CTL_BYTES;
constexpr size_t WS_WIN = WS_MOD + al256((size_t)2 * 17 * 6144 * 4);
constexpr size_t WS_WOUT = WS_WIN + (size_t)2 * 2816 * 1024 * 2;
constexpr size_t WS_WGU = WS_WOUT + (size_t)2 * 1024 * 1024 * 2;
constexpr size_t WS_WD = WS_WGU + (size_t)2 * 16 * 1024 * 1024 * 2;
constexpr size_t WS_RGW = WS_WD + (size_t)2 * 1024 * 8192 * 2;
constexpr size_t WS_TCAR = WS_RGW + (size_t)32 * 4096 * 2;
constexpr size_t WS_TOKINFO = WS_TCAR + (size_t)2 * 144 * 256 * 2 * 4;
constexpr size_t WS_SGU = WS_TOKINFO + (size_t)MT * 16;
constexpr size_t WS_TD = WS_SGU + (size_t)2 * 16 * 1024 * 4;
constexpr size_t WS_SWIN = WS_TD + (size_t)2 * 16 * 512 * 4;
constexpr size_t WS_SWO = WS_SWIN + al256((size_t)2 * 2816 * 4);
constexpr size_t WS_ROWW = WS_SWO + (size_t)2 * 1024 * 4;
constexpr size_t WS_HS = WS_ROWW + al256((size_t)MPERM * 16);
constexpr size_t WS_H = WS_HS + al256((size_t)MT * 4);
constexpr size_t WS_U = WS_H + (size_t)MT * 1024 * 2;
constexpr size_t U_BYTES = ((size_t)MT * UW * 2 > (size_t)(MPERM + NLAT) * 1024 * 2) ? (size_t)MT * UW * 2 : (size_t)(MPERM + NLAT) * 1024 * 2;
constexpr size_t WS_C = WS_U + U_BYTES;
constexpr size_t WS_VT = WS_C;
constexpr size_t WS_YNA = WS_VT + (size_t)512 * MT * 2;
constexpr size_t WS_HLOC = WS_YNA + (size_t)MT * 512 * 2;
constexpr size_t WS_CUMA = WS_HLOC + (size_t)2 * MT * 256 * 2;
constexpr size_t WS_END = WS_CUMA + (size_t)2 * MT * 256 * 2;
static_assert((size_t)MPERM * 1024 * 2 <= (size_t)MT * UW * 2, "HP fits in U");
static_assert((size_t)MPERM * 1024 * 2 <= WS_END - WS_C, "HID fits in C");
constexpr int CW_BAR = 0;
constexpr int CW_CNT = 4096;
constexpr int CW_CQ = 8192;

constexpr int LDS_STAGE = 131072;
constexpr int LDS_MISC = LDS_STAGE;
constexpr int LDS_BYTES = LDS_STAGE + 16384;

#define XB_TMO      128
#define XB_XCNT(j)  (256  + 64 * (j))
#define XB_XSUB(j)  (1280 + 64 * (j))
#define XB_XGEN(j)  (2304 + 64 * (j))
#define XB_TOP      3328
#define XB_TOPGEN   3392
#define XCD_BAR_WORDS 3456
#define XB_SPIN_CAP (1u << 18)

__device__ __forceinline__ unsigned xb_ld(unsigned* p)              { return __hip_atomic_load(p, __ATOMIC_RELAXED, __HIP_MEMORY_SCOPE_AGENT); }
__device__ __forceinline__ unsigned xb_add(unsigned* p, unsigned v) { return __hip_atomic_fetch_add(p, v, __ATOMIC_RELAXED, __HIP_MEMORY_SCOPE_AGENT); }
__device__ __forceinline__ unsigned xb_xcc_id() { return (unsigned)__builtin_amdgcn_s_getreg((3 << 11) | 20) & 0xFu; }
#define XB_SPIN(cond, bar) do { unsigned _sp = 0; while (cond) { __builtin_amdgcn_s_sleep(1); \
    if ((++_sp & 255u) == 0u) { if (xb_ld(&(bar)[XB_TMO])) break; if (_sp > XB_SPIN_CAP) { atomicAdd(&(bar)[XB_TMO], 1u); break; } } } } while (0)

struct XcdBarrier { unsigned* bar; unsigned x; volatile LAS unsigned* st; };

__device__ __forceinline__ XcdBarrier xcd_barrier_post(unsigned* bar, volatile LAS unsigned* st, int tid0) {
    XcdBarrier b; b.bar = bar; b.x = xb_xcc_id(); b.st = st;
    if (tid0 == 0) (void)xb_add(&bar[XB_XCNT(b.x)], 1u);
    return b;
}
__device__ __forceinline__ void xcd_barrier_complete(unsigned* bar, unsigned x, unsigned& nloc, unsigned& nx) {
    const unsigned G = gridDim.x * gridDim.y * gridDim.z;
    unsigned sum, cnt, mine, sp = 0u;
    for (;;) {
        sum = 0u; cnt = 0u; mine = 0u;
#pragma unroll
        for (unsigned j = 0; j < 16; ++j) { const unsigned c = xb_ld(&bar[XB_XCNT(j)]); sum += c; cnt += (c > 0u) ? 1u : 0u; mine = (j == x) ? c : mine; }
        if (sum == G) break;
        __builtin_amdgcn_s_sleep(1);
        if ((++sp & 255u) == 0u) { if (xb_ld(&bar[XB_TMO])) break; if (sp > XB_SPIN_CAP) { atomicAdd(&bar[XB_TMO], 1u); break; } }
    }
    nloc = mine > 0u ? mine : 1u; nx = cnt > 0u ? cnt : 1u;
}
__device__ __forceinline__ void xcd_barrier(const XcdBarrier& b, int tid0) {
    asm volatile("s_waitcnt vmcnt(0)" ::: "memory");
    __syncthreads();
    if (tid0 == 0) {
        unsigned* bar = b.bar;
        __builtin_amdgcn_s_waitcnt(0);
        unsigned nloc = b.st[0], nx = b.st[1];
        if (nloc == 0u) { xcd_barrier_complete(bar, b.x, nloc, nx); b.st[0] = nloc; b.st[1] = nx; }
        const unsigned old = xb_add(&bar[XB_XSUB(b.x)], 1u);
        const unsigned gen = old / nloc;
        if (old + 1u == (gen + 1u) * nloc) {
            __builtin_amdgcn_fence(__ATOMIC_RELEASE, "agent");
            asm volatile("s_waitcnt vmcnt(0)" ::: "memory");
            const unsigned og = xb_add(&bar[XB_TOP], 1u);
            const unsigned tg = og / nx;
            if (og + 1u == (tg + 1u) * nx) xb_add(&bar[XB_TOPGEN], 1u);
            else XB_SPIN(xb_ld(&bar[XB_TOPGEN]) == tg, bar);
            __builtin_amdgcn_fence(__ATOMIC_ACQUIRE, "agent");
            xb_add(&bar[XB_XGEN(b.x)], 1u);
            asm volatile("s_waitcnt vmcnt(0)" ::: "memory");
        } else {
            XB_SPIN(xb_ld(&bar[XB_XGEN(b.x)]) == gen, bar);
            __builtin_amdgcn_fence(__ATOMIC_ACQUIRE, "agent");
            asm volatile("s_waitcnt vmcnt(0)" ::: "memory");
        }
    }
    __syncthreads();
}

typedef __bf16 bf16v2_t __attribute__((ext_vector_type(2)));
__device__ __forceinline__ unsigned cvt_pk_bf16(float lo, float hi) { const f32x2 v = {lo, hi}; const bf16v2_t b = __builtin_convertvector(v, bf16v2_t); return __builtin_bit_cast(unsigned, b); }
__device__ __forceinline__ float bf_lo(unsigned w) { return __uint_as_float(w << 16); }
__device__ __forceinline__ float bf_hi(unsigned w) { return __uint_as_float(w & 0xffff0000u); }
__device__ __forceinline__ float bf2f(bf16_t h) { return __uint_as_float(((unsigned)h) << 16); }
__device__ __forceinline__ bf16_t f2bf(float f) { return (bf16_t)(cvt_pk_bf16(f, 0.f) & 0xffffu); }
template <int CTRL, int ROWMASK> __device__ __forceinline__ float dpp_f(float v) { return __builtin_bit_cast(float, __builtin_amdgcn_update_dpp(0, __builtin_bit_cast(int, v), CTRL, ROWMASK, 0xF, false)); }
__device__ __forceinline__ float wave_sum(float v) {
    v += dpp_f<0xB1, 0xF>(v); v += dpp_f<0x4E, 0xF>(v); v += dpp_f<0x141, 0xF>(v); v += dpp_f<0x140, 0xF>(v);
    v += dpp_f<0x142, 0xA>(v); v += dpp_f<0x143, 0xC>(v);
    return __builtin_bit_cast(float, __builtin_amdgcn_readlane(__builtin_bit_cast(int, v), 63));
}
__device__ __forceinline__ float wave_max(float v) {
    v = fmaxf(v, dpp_f<0xB1, 0xF>(v)); v = fmaxf(v, dpp_f<0x4E, 0xF>(v)); v = fmaxf(v, dpp_f<0x141, 0xF>(v)); v = fmaxf(v, dpp_f<0x140, 0xF>(v));
    v = fmaxf(v, dpp_f<0x142, 0xA>(v)); v = fmaxf(v, dpp_f<0x143, 0xC>(v));
    return __builtin_bit_cast(float, __builtin_amdgcn_readlane(__builtin_bit_cast(int, v), 63));
}
__device__ __forceinline__ unsigned cvt_fp8x4(float a, float b, float c, float d) {
    int w = 0; w = __builtin_amdgcn_cvt_pk_fp8_f32(a, b, w, false); w = __builtin_amdgcn_cvt_pk_fp8_f32(c, d, w, true); return (unsigned)w; }
constexpr float FP8_TOP = 440.0f;
constexpr float HID_CH = 64.0f;
__device__ __forceinline__ float sigmoidf_(float x) { return __builtin_amdgcn_rcpf(1.0f + __builtin_amdgcn_exp2f(-x * LOG2E)); }
__device__ __forceinline__ float gelu_tanh(float x) {
    const float u = 0.7978845608028654f * (x + 0.044715f * x * x * x);
    return x * sigmoidf_(2.0f * u);
}

struct KArgs { const float* in[25]; float* out; unsigned char* ws; int ph_lo, ph_hi; };
typedef const KArgs __attribute__((address_space(4)))* KAp;
__device__ __forceinline__ KAp ka_get() { KAp p = (KAp)__builtin_amdgcn_kernarg_segment_ptr(); asm volatile("" : "+s"(p)); return p; }

__device__ __forceinline__ int lane_id_() { unsigned z = 0u; asm volatile("" : "+v"(z)); return (int)__builtin_amdgcn_mbcnt_hi(~0u, __builtin_amdgcn_mbcnt_lo(~0u, z)); }
__device__ __forceinline__ int op_tid_w(int wv) { int t = wv * 64 + lane_id_(); asm volatile("" : "+v"(t)); return t; }
#define op_tid() op_tid_w(wv)
__device__ __forceinline__ int op_blk() { int t = blockIdx.x; asm volatile("" : "+s"(t)); return t; }
__device__ __forceinline__ int op_grid() { int t = gridDim.x; asm volatile("" : "+s"(t)); return t; }

namespace pg8 {
constexpr int BM = 256, BK = 64, HALF = 128, HTB = HALF * BK * 2, STAGE_BYTES = 8 * HTB;
__host__ __device__ __forceinline__ int lds_byte(int r, int c) { const int st = (r >> 4) * 2 + (c >> 5), rr = r & 15, cc = c & 31, ob = rr * 64 + cc * 2; return st * 1024 + (ob ^ (((ob >> 9) & 1) << 5)); }
__host__ __device__ __forceinline__ void stage_rc(int b, int& R, int& C) { const int st = b / 1024, sb = b % 1024, swz = sb ^ (((sb >> 9) & 1) << 5); R = (st >> 1) * 16 + swz / 64; C = (st & 1) * 32 + (swz % 64) / 2; }
__host__ __device__ __forceinline__ int perm32(int rho) { const int n = rho >> 4, i = rho & 15; return 8 * (i >> 2) + 4 * n + (i & 3); }

struct Unit { const char* a; const char* b0; const char* b1; int pm, pn, x0, x1; };

#ifndef PG8_SP2
#define PG8_SP2 true
#endif
#ifndef PG8_ALIGN
#define PG8_ALIGN true
#endif
template <class Epi, class Sched, bool FP8 = false, bool GATHER = false, bool SP2 = PG8_SP2, bool ALIGN_EPI = PG8_ALIGN>
__device__ __forceinline__ void gemm_phase(const int wv, LAS unsigned char* lds, const int K, const int lda, const int ldb, const Sched& S, const Epi& E) {
    const int tid = op_tid(), wid = __builtin_amdgcn_readfirstlane(tid >> 6), lane = tid & 63, wr = wid >> 2, wc = wid & 3, fr = lane & 15, fq = lane >> 4;
    const int nt = K / BK, nth = nt / 2;
    unsigned voffA[2], voffB[2];
#pragma unroll
    for (int i = 0; i < 2; ++i) { int R, C; stage_rc(tid * 16 + i * 8192, R, C); const int Rb = Epi::PERM ? ((R & ~31) + perm32(R & 31)) : R;
        voffA[i] = (unsigned)(R * lda + C) * 2u; voffB[i] = (unsigned)(Rb * ldb + C) * 2u; }
    const size_t kstep = (size_t)(BK * 2);
    const size_t hstepA = (size_t)HALF * lda * 2, hstepB = (size_t)HALF * ldb * 2;
    const unsigned ldsw = (unsigned)wid * 1024u;
    const int aoff = lds_byte(wr * 64 + fr, fq * 8), boff = lds_byte(wc * 32 + fr, fq * 8);
#define PG8_SA(b, h) (((b) * 2 + (h)) * HTB)
#define PG8_SB(b, h) ((4 + (b) * 2 + (h)) * HTB)
#define PG8_STAGE(bufoff, gbase, voff) do { _Pragma("unroll") for (int _i = 0; _i < 2; ++_i) \
        __builtin_amdgcn_global_load_lds((const unsigned*)((const char*)(gbase) + (voff)[_i]), (LAS unsigned*)(lds + (bufoff) + ldsw + _i * 8192), 16, 0, 0); } while (0)
#define PG8_LDA(dst, b, h) do { _Pragma("unroll") for (int m = 0; m < 4; ++m) _Pragma("unroll") for (int k = 0; k < 2; ++k) dst[m].k[k] = *(const LAS bf16x8*)(lds + PG8_SA(b, h) + aoff + m * 2048 + k * 1024); } while (0)
#define PG8_LDB(dst, b, h) do { _Pragma("unroll") for (int n = 0; n < 2; ++n) _Pragma("unroll") for (int k = 0; k < 2; ++k) dst[n].k[k] = *(const LAS bf16x8*)(lds + PG8_SB(b, h) + boff + n * 2048 + k * 1024); } while (0)
#define PG8_MMA(ai, bj, At, Bt) do { __builtin_amdgcn_s_setprio(1); _Pragma("unroll") for (int m = 0; m < 4; ++m) _Pragma("unroll") for (int n = 0; n < 2; ++n) { \
        if (FP8) { i32x8 b8_ = __builtin_bit_cast(i32x8, Bt[n]), a8_ = __builtin_bit_cast(i32x8, At[m]); \
              \
              \
            asm volatile("v_mfma_f32_16x16x128_f8f6f4 %0, %1, %2, %0" : "+v"(acc[ai][bj][m][n]) : "v"(b8_), "v"(a8_)); } \
        else { _Pragma("unroll") for (int k = 0; k < 2; ++k) acc[ai][bj][m][n] = __builtin_amdgcn_mfma_f32_16x16x32_bf16(Bt[n].k[k], At[m].k[k], acc[ai][bj][m][n], 0, 0, 0); } } \
        __builtin_amdgcn_s_setprio(0); } while (0)
#define PG8_WAIT_V(n) asm volatile("s_waitcnt vmcnt(" #n ")" ::: "memory")
#define PG8_WAIT_L(n) asm volatile("s_waitcnt lgkmcnt(" #n ")" ::: "memory")
#define PG8_BAR __builtin_amdgcn_s_barrier()
#define PG8_SCHED __builtin_amdgcn_sched_barrier(0)
    Unit cur, nxt; int ui = 0;
    if (!S.next(0, cur)) return;
    f32x4 acc[2][2][4][2];
#pragma unroll
    for (int a = 0; a < 2; ++a)
#pragma unroll
        for (int b = 0; b < 2; ++b)
#pragma unroll
            for (int m = 0; m < 4; ++m)
#pragma unroll
                for (int n = 0; n < 2; ++n) acc[a][b][m][n] = (f32x4){0.f, 0.f, 0.f, 0.f};
    struct Frag2 { bf16x8 k[2]; };
    Frag2 At[4], B0[2], B1[2];
    const char* cA = cur.a; const char* cB = cur.b0; const char* cB1 = cur.b1;
    static_assert(!GATHER || SP2, "gather mode: SP2 K-loop only");
    unsigned vA0[2] = {0u, 0u}, vA1[2] = {0u, 0u}, nA0[2] = {0u, 0u}, nA1[2] = {0u, 0u};
#define PG8_GOFFS(u, ord, o0, o1) do { _Pragma("unroll") for (int i_ = 0; i_ < 2; ++i_) { int R_, C_; stage_rc(tid * 16 + i_ * 8192, R_, C_); \
        const int t0_ = S.tix[(ord) * 256 + R_], t1_ = S.tix[(ord) * 256 + R_ + 128];     \
        o0[i_] = (unsigned)t0_ * (unsigned)(lda * 2) + (unsigned)C_ * 2u; o1[i_] = (unsigned)t1_ * (unsigned)(lda * 2) + (unsigned)C_ * 2u; } } while (0)
#define PG8_STAGE_A(b, h, base, o0, o1) do { if constexpr (GATHER) { if (h) PG8_STAGE(PG8_SA(b, h), base, o1); else PG8_STAGE(PG8_SA(b, h), base, o0); } \
        else PG8_STAGE(PG8_SA(b, h), (base) + ((h) ? hstepA : (size_t)0), voffA); } while (0)
    if constexpr (GATHER) PG8_GOFFS(cur, 0, vA0, vA1);
    if constexpr (SP2) {
        PG8_STAGE(PG8_SB(0, 0), cB, voffB); PG8_STAGE(PG8_SB(0, 1), cB + hstepB, voffB); PG8_STAGE_A(0, 0, cA, vA0, vA1); PG8_STAGE_A(0, 1, cA, vA0, vA1);
        if (wr == 1) PG8_BAR;
        PG8_WAIT_V(2); PG8_BAR;
        PG8_STAGE(PG8_SB(1, 0), cB + kstep, voffB); PG8_STAGE_A(1, 0, cA + kstep, vA0, vA1); PG8_STAGE(PG8_SB(1, 1), cB + hstepB + kstep, voffB);
        PG8_WAIT_V(6); PG8_BAR;
    } else {
    PG8_STAGE(PG8_SB(0, 0), cB, voffB); PG8_STAGE(PG8_SA(0, 0), cA, voffA); PG8_STAGE(PG8_SB(0, 1), cB + hstepB, voffB); PG8_STAGE(PG8_SA(0, 1), cA + hstepA, voffA);
    if (wr == 1) PG8_BAR;
    PG8_WAIT_V(4); PG8_BAR;
    PG8_STAGE(PG8_SB(1, 0), cB + kstep, voffB); PG8_STAGE(PG8_SA(1, 0), cA + kstep, voffA); PG8_STAGE(PG8_SB(1, 1), cB + hstepB + kstep, voffB);
    PG8_WAIT_V(6); PG8_BAR;
    }
    for (;;) {
        const bool has_next = S.next(ui + 1, nxt);
        const char* nA = has_next ? nxt.a : cA; const char* nB = has_next ? nxt.b0 : cB;
        if constexpr (GATHER) { if (has_next) PG8_GOFFS(nxt, ui + 1, nA0, nA1); else { nA0[0] = vA0[0]; nA0[1] = vA0[1]; nA1[0] = vA1[0]; nA1[1] = vA1[1]; } }
#pragma nounroll
        for (int t = 0; t < nt; t += 2) {
            const bool last = (t == nt - 2);
            const int t2 = t + 2;
            const char* a1 = cA + (size_t)(t + 1) * kstep;
            const char* bc2 = (t2 < nth) ? cB + (size_t)t2 * kstep : cB1 + (size_t)(t2 - nth) * kstep;
            const char* a2 = last ? nA : cA + (size_t)t2 * kstep; const char* b2 = last ? nB : bc2;
            const char* a3 = a2 + kstep; const char* b3 = b2 + kstep;
            unsigned sA0[2], sA1[2];
            if constexpr (GATHER) { sA0[0] = last ? nA0[0] : vA0[0]; sA0[1] = last ? nA0[1] : vA0[1]; sA1[0] = last ? nA1[0] : vA1[0]; sA1[1] = last ? nA1[1] : vA1[1]; }
            if constexpr (SP2) {
            PG8_LDB(B0, 0, 0); PG8_LDB(B1, 0, 1); PG8_SCHED; PG8_LDA(At, 0, 0); PG8_STAGE_A(1, 1, a1, vA0, vA1);
            PG8_WAIT_V(8); PG8_WAIT_L(0); PG8_BAR; PG8_MMA(0, 0, At, B0); PG8_MMA(0, 1, At, B1); PG8_BAR; PG8_SCHED;
            PG8_LDA(At, 0, 1); PG8_STAGE(PG8_SB(0, 0), b2, voffB); PG8_STAGE(PG8_SB(0, 1), b2 + hstepB, voffB); PG8_STAGE_A(0, 0, a2, sA0, sA1);
            PG8_WAIT_V(8); PG8_WAIT_L(0); PG8_BAR; PG8_MMA(1, 0, At, B0); PG8_MMA(1, 1, At, B1); PG8_BAR; PG8_SCHED;
            PG8_LDB(B0, 1, 0); PG8_LDB(B1, 1, 1); PG8_SCHED; PG8_LDA(At, 1, 0); PG8_STAGE_A(0, 1, a2, sA0, sA1);
            PG8_WAIT_V(8); PG8_WAIT_L(0); PG8_BAR; PG8_MMA(0, 0, At, B0); PG8_MMA(0, 1, At, B1); PG8_BAR; PG8_SCHED;
            PG8_LDA(At, 1, 1); PG8_STAGE(PG8_SB(1, 0), b3, voffB); PG8_STAGE(PG8_SB(1, 1), b3 + hstepB, voffB); PG8_STAGE_A(1, 0, a3, sA0, sA1);
            PG8_WAIT_V(8); PG8_WAIT_L(0); PG8_BAR; PG8_MMA(1, 0, At, B0); PG8_MMA(1, 1, At, B1); PG8_BAR; PG8_SCHED;
            } else {
            PG8_LDB(B0, 0, 0); PG8_SCHED; PG8_LDA(At, 0, 0); PG8_STAGE(PG8_SA(1, 1), a1 + hstepA, voffA);
            PG8_WAIT_L(8); PG8_BAR; PG8_WAIT_L(0); PG8_MMA(0, 0, At, B0); PG8_BAR; PG8_SCHED;
            PG8_LDB(B1, 0, 1); PG8_STAGE(PG8_SB(0, 0), b2, voffB);
            PG8_BAR; PG8_WAIT_L(0); PG8_MMA(0, 1, At, B1); PG8_BAR;
            PG8_LDA(At, 0, 1); PG8_STAGE(PG8_SA(0, 0), a2, voffA);
            PG8_BAR; PG8_WAIT_L(0); PG8_MMA(1, 0, At, B0); PG8_BAR; PG8_SCHED;
            PG8_STAGE(PG8_SB(0, 1), b2 + hstepB, voffB);
            PG8_WAIT_V(6); PG8_BAR; PG8_MMA(1, 1, At, B1); PG8_BAR;
            PG8_LDB(B0, 1, 0); PG8_SCHED; PG8_LDA(At, 1, 0); PG8_STAGE(PG8_SA(0, 1), a2 + hstepA, voffA);
            PG8_WAIT_L(8); PG8_BAR; PG8_WAIT_L(0); PG8_MMA(0, 0, At, B0); PG8_BAR; PG8_SCHED;
            PG8_LDB(B1, 1, 1); PG8_STAGE(PG8_SB(1, 0), b3, voffB);
            PG8_BAR; PG8_WAIT_L(0); PG8_MMA(0, 1, At, B1); PG8_BAR;
            PG8_LDA(At, 1, 1); PG8_STAGE(PG8_SA(1, 0), a3, voffA);
            PG8_BAR; PG8_WAIT_L(0); PG8_MMA(1, 0, At, B0); PG8_BAR; PG8_SCHED;
            PG8_STAGE(PG8_SB(1, 1), b3 + hstepB, voffB);
            PG8_WAIT_V(6); PG8_BAR; PG8_MMA(1, 1, At, B1); PG8_BAR;
            }
        }
        if constexpr (ALIGN_EPI) { if (wr == 0) PG8_BAR; }
        if (FP8) asm volatile("s_nop 15\n\ts_nop 15\n\ts_nop 7" ::: "memory");
        { int fr_ = fr, fq_ = fq; asm volatile("" : "+v"(fr_), "+v"(fq_));
          E(acc, cur, wr, wc, fr_, fq_); }
        if (FP8) asm volatile("s_nop 3" ::: "memory");
        if (!has_next) break;
#pragma unroll
        for (int a = 0; a < 2; ++a)
#pragma unroll
            for (int b = 0; b < 2; ++b)
#pragma unroll
                for (int m = 0; m < 4; ++m)
#pragma unroll
                    for (int n = 0; n < 2; ++n) acc[a][b][m][n] = (f32x4){0.f, 0.f, 0.f, 0.f};
        cur = nxt; cA = cur.a; cB = cur.b0; cB1 = cur.b1; ++ui;
        if constexpr (GATHER) { vA0[0] = nA0[0]; vA0[1] = nA0[1]; vA1[0] = nA1[0]; vA1[1] = nA1[1]; }
        if constexpr (ALIGN_EPI) { if (wr == 1) PG8_BAR; }
    }
    PG8_WAIT_V(0);
    if constexpr (!ALIGN_EPI) { if (wr == 0) PG8_BAR; }
    PG8_BAR;
#undef PG8_SA
#undef PG8_SB
#undef PG8_STAGE
#undef PG8_STAGE_A
#undef PG8_GOFFS
#undef PG8_LDA
#undef PG8_LDB
#undef PG8_MMA
#undef PG8_WAIT_V
#undef PG8_WAIT_L
#undef PG8_BAR
#undef PG8_SCHED
}

__device__ __forceinline__ void tile_order(int L, int nM, int nN, int& pm, int& pn) {
    const int nwg = nM * nN; int wgid = L;
    { const int q = nwg / 8, r = nwg % 8, xcd = wgid % 8, off = wgid / 8; wgid = (xcd < r ? xcd * (q + 1) : r * (q + 1) + (xcd - r) * q) + off; }
    const int nig = 8 * nN, gid = wgid / nig, fm = gid * 8, gsz = (nM - fm) < 8 ? (nM - fm) : 8;
    pm = fm + ((wgid % nig) % gsz); pn = (wgid % nig) / gsz;
}
}

struct SchedInproj {
    int G, c, nrt; const char* H; const char* Win; int skipctx;
    __device__ __forceinline__ bool next(int i, pg8::Unit& u) const {
        const int L = i * G + c, nfull = skipctx ? 128 : nrt, n0 = nfull * 9, n1 = n0 + (skipctx ? 16 * 3 : 0);
        if (L < n1) { int pm, pn;
            if (L < n0) pg8::tile_order(L, nfull, 9, pm, pn); else { const int q = L - n0; pm = 128 + q / 3; pn = 2 + q % 3; }
            u.a = H + (size_t)pm * (256 * 1024); const int brow = pn < 4 ? pn * 256 : 1536 + (pn - 4) * 256;
            u.b0 = Win + (size_t)brow * 1024; u.b1 = u.b0 + 512; u.pm = pm; u.pn = pn; u.x0 = 0; u.x1 = brow; return true; }
        const int L2 = L - n1; if (L2 >= 2 * nrt) return false;
        const int x8 = L2 & 7, q8 = L2 >> 3, pa = q8 & 1, pt = x8 * (nrt >> 3) + (q8 >> 1);
        u.a = Win + (size_t)(1024 + pa * 256) * 1024; u.b0 = H + (size_t)pt * (256 * 1024); u.b1 = u.b0 + 512; u.pm = pa; u.pn = pt; u.x0 = 1; u.x1 = 0; return true;
    }
};
struct EpiInproj {
    static constexpr bool PERM = true;
    bf16_t* U; bf16_t* VT; const float* hs; const float* sw;
    __device__ __forceinline__ void operator()(const f32x4 (&acc)[2][2][4][2], const pg8::Unit& u, int wr, int wc, int fr, int fq) const {
        const int row0 = wr * 64 + fr, col0 = wc * 32 + 8 * fq;
        const float* rs = (u.x0 == 0 ? hs + u.pm * 256 : sw + 1024 + u.pm * 256) + row0;
        const float* cs = (u.x0 == 0 ? sw + u.x1 : hs + u.pn * 256) + col0;
        const f32x4 c00 = *(const f32x4*)cs, c01 = *(const f32x4*)(cs + 4), c10 = *(const f32x4*)(cs + 128), c11 = *(const f32x4*)(cs + 132);
        float rv[8];
#pragma unroll
        for (int i = 0; i < 8; ++i) rv[i] = rs[(i >> 2) * 128 + (i & 3) * 16];
        __builtin_amdgcn_sched_barrier(0);
        if (u.x0 == 0 && u.pn >= 7) {
            bf16_t* cb = U + (size_t)u.pm * 256 * UW + UCX + (u.pn - 7) * 128 + col0;
            const f32x4 p0 = c00 * c10, p1 = c01 * c11;
#pragma unroll
            for (int ai = 0; ai < 2; ++ai)
#pragma unroll
                for (int m = 0; m < 4; ++m) { const float r1 = rv[ai * 4 + m], r2 = r1 * r1;
                    const f32x4 a0 = acc[ai][0][m][0] * acc[ai][1][m][0] * (p0 * r2), a1 = acc[ai][0][m][1] * acc[ai][1][m][1] * (p1 * r2);
                    u32x4 w; w.x = cvt_pk_bf16(a0[0], a0[1]); w.y = cvt_pk_bf16(a0[2], a0[3]); w.z = cvt_pk_bf16(a1[0], a1[1]); w.w = cvt_pk_bf16(a1[2], a1[3]);
                    *(u32x4*)(cb + (size_t)(row0 + ai * 128 + m * 16) * UW) = w; }
            return;
        }
#pragma unroll
        for (int ai = 0; ai < 2; ++ai)
#pragma unroll
            for (int m = 0; m < 4; ++m) { const int rr = row0 + ai * 128 + m * 16; const float r1 = rv[ai * 4 + m];
                bf16_t* rowp = u.x0 == 0 ? U + (size_t)(u.pm * 256 + rr) * UW + u.pn * 256 + col0
                                         : VT + (size_t)((u.pm * 256 + rr) >> 1) * (2 * MT) + (size_t)(u.pn * 8 + wc) * 64 + (rr & 1) * 32 + 8 * fq;
#pragma unroll
                for (int bj = 0; bj < 2; ++bj) { const f32x4 v0 = acc[ai][bj][m][0] * ((bj ? c10 : c00) * r1), v1 = acc[ai][bj][m][1] * ((bj ? c11 : c01) * r1);
                    u32x4 w; w.x = cvt_pk_bf16(v0[0], v0[1]); w.y = cvt_pk_bf16(v0[2], v0[3]); w.z = cvt_pk_bf16(v1[0], v1[1]); w.w = cvt_pk_bf16(v1[2], v1[3]);
                    *(u32x4*)(rowp + (u.x0 == 0 ? bj * 128 : bj * 256)) = w; } }
    }
};
struct SchedOut {
    int G, c, nrt; const char* A; const char* W;
    __device__ __forceinline__ bool next(int i, pg8::Unit& u) const {
        const int L = i * G + c; if (L >= nrt * 4) return false;
        int pm, pn; pg8::tile_order(L, nrt, 4, pm, pn);
        u.a = A + (size_t)pm * (256 * 1024); u.b0 = W + (size_t)pn * (256 * 1024); u.b1 = u.b0 + 512; u.pm = pm; u.pn = pn; u.x0 = 0; u.x1 = 0; return true;
    }
};
struct EpiStore {
    static constexpr bool PERM = true;
    bf16_t* Y;
    __device__ __forceinline__ void operator()(const f32x4 (&acc)[2][2][4][2], const pg8::Unit& u, int wr, int wc, int fr, int fq) const {
        bf16_t* base = Y + (size_t)u.pm * 256 * D + u.pn * 256;
        const int row0 = wr * 64 + fr, col0 = wc * 32 + 8 * fq;
#pragma unroll
        for (int ai = 0; ai < 2; ++ai)
#pragma unroll
            for (int m = 0; m < 4; ++m) { bf16_t* rowp = base + (size_t)(row0 + ai * 128 + m * 16) * D + col0;
#pragma unroll
                for (int bj = 0; bj < 2; ++bj) { const f32x4 v0 = acc[ai][bj][m][0], v1 = acc[ai][bj][m][1];
                    u32x4 w; w.x = cvt_pk_bf16(v0[0], v0[1]); w.y = cvt_pk_bf16(v0[2], v0[3]); w.z = cvt_pk_bf16(v1[0], v1[1]); w.w = cvt_pk_bf16(v1[2], v1[3]);
                    *(u32x4*)(rowp + bj * 128) = w; } }
    }
};
struct EpiStoreRC {
    static constexpr bool PERM = true;
    bf16_t* Y; const float* rs; const float* cs;
    __device__ __forceinline__ void operator()(const f32x4 (&acc)[2][2][4][2], const pg8::Unit& u, int wr, int wc, int fr, int fq) const {
        bf16_t* base = Y + (size_t)u.pm * 256 * D + u.pn * 256;
        const int row0 = wr * 64 + fr, col0 = wc * 32 + 8 * fq;
        const float* cp = cs + u.pn * 256 + col0; const float* rp = rs + u.pm * 256 + row0;
        const f32x4 c00 = *(const f32x4*)cp, c01 = *(const f32x4*)(cp + 4), c10 = *(const f32x4*)(cp + 128), c11 = *(const f32x4*)(cp + 132);
        float rv[8];
#pragma unroll
        for (int i = 0; i < 8; ++i) rv[i] = rp[(i >> 2) * 128 + (i & 3) * 16];
        __builtin_amdgcn_sched_barrier(0);
#pragma unroll
        for (int ai = 0; ai < 2; ++ai)
#pragma unroll
            for (int m = 0; m < 4; ++m) { bf16_t* rowp = base + (size_t)(row0 + ai * 128 + m * 16) * D + col0; const float sr = rv[ai * 4 + m];
#pragma unroll
                for (int bj = 0; bj < 2; ++bj) { const f32x4 v0 = acc[ai][bj][m][0] * ((bj ? c10 : c00) * sr), v1 = acc[ai][bj][m][1] * ((bj ? c11 : c01) * sr);
                    u32x4 w; w.x = cvt_pk_bf16(v0[0], v0[1]); w.y = cvt_pk_bf16(v0[2], v0[3]); w.z = cvt_pk_bf16(v1[0], v1[1]); w.w = cvt_pk_bf16(v1[2], v1[3]);
                    *(u32x4*)(rowp + bj * 128) = w; } }
    }
};
struct EpiStoreS {
    static constexpr bool PERM = true;
    bf16_t* Y; float mul;
    __device__ __forceinline__ void operator()(const f32x4 (&acc)[2][2][4][2], const pg8::Unit& u, int wr, int wc, int fr, int fq) const {
        bf16_t* base = Y + (size_t)u.pm * 256 * D + u.pn * 256;
        const int row0 = wr * 64 + fr, col0 = wc * 32 + 8 * fq;
#pragma unroll
        for (int ai = 0; ai < 2; ++ai)
#pragma unroll
            for (int m = 0; m < 4; ++m) { bf16_t* rowp = base + (size_t)(row0 + ai * 128 + m * 16) * D + col0;
#pragma unroll
                for (int bj = 0; bj < 2; ++bj) { const f32x4 v0 = acc[ai][bj][m][0] * mul, v1 = acc[ai][bj][m][1] * mul;
                    u32x4 w; w.x = cvt_pk_bf16(v0[0], v0[1]); w.y = cvt_pk_bf16(v0[2], v0[3]); w.z = cvt_pk_bf16(v1[0], v1[1]); w.w = cvt_pk_bf16(v1[2], v1[3]);
                    *(u32x4*)(rowp + bj * 128) = w; } }
    }
};
struct SchedMoe {
    int G, c, NU, ntiles; const LAS int* tst;
    const char* A; const char* W; int down; const f32x4* rw; const LAS int* tix;
    __device__ __forceinline__ bool next(int i, pg8::Unit& u) const {
        int mt, pn;
        if ((G & 7) == 0) {
            const int x = c & 7, q = i * (G >> 3) + (c >> 3), t = q / NU; pn = q - t * NU;
            const int tq = ntiles >> 3, tr = ntiles & 7, nx = tq + (x < tr ? 1 : 0);
            if (t >= nx) return false;
            mt = x * tq + (x < tr ? x : tr) + t;
        } else { const int L = i * G + c; if (L >= ntiles * NU) return false; mt = L / NU; pn = L - mt * NU; }
        const int bk = __builtin_amdgcn_readfirstlane(tst[32 + mt]);
        const int grp = bk / 6, p = bk - grp * 6;
        const int lo = p < 3 ? 0 : (p < 5 ? 1 : 2), hi = p < 3 ? p + 1 : (p < 5 ? p - 1 : 3);
        const int elo = grp * 4 + lo, ehi = grp * 4 + hi;
        u.a = A + (size_t)mt * (256 * 2048); u.pm = mt; u.pn = pn; u.x0 = 0; u.x1 = 0;
        if (!down) { const int which = pn >> 2, j = pn & 3; const int e = which ? ehi : elo;
            u.b0 = W + (size_t)e * (1024 * 1024) + (size_t)j * (256 * 1024); u.b1 = u.b0 + 512; u.x0 = e; u.a = A;
            const int jt = mt - tst[bk], left = tst[208 + bk] - jt * 256; u.x1 = (bk * MT + jt * 256) | ((left < 256 ? left : 256) << 20); }
        else { const char* wb = W + (size_t)pn * 256 * 512; u.b0 = wb + (size_t)elo * (1024 * 512); u.b1 = wb + (size_t)ehi * (1024 * 512); u.a = A + (size_t)mt * (256 * 1024); }
        return true;
    }
};
struct EpiGateUp {
    static constexpr bool PERM = true;
    unsigned char* HID; const f32x4* roww; const float* sgu; const float* tdl;
    __device__ __forceinline__ void operator()(const f32x4 (&acc)[2][2][4][2], const pg8::Unit& u, int wr, int wc, int fr, int fq) const {
        const int which = u.pn >> 2, j = u.pn & 3, cf = j * 128 + wc * 32 + 8 * fq;
        const int prow0 = u.pm * 256 + wr * 64 + fr, col0 = which * 512 + cf;
        const float* sp = sgu + (size_t)u.x0 * 1024 + j * 256 + wc * 32 + 8 * fq;
        const float* tq = tdl + (size_t)u.x0 * 512 + cf;
        const f32x4 sg0 = *(const f32x4*)sp, sg1 = *(const f32x4*)(sp + 4), ut0 = *(const f32x4*)(sp + 128) * *(const f32x4*)tq, ut1 = *(const f32x4*)(sp + 132) * *(const f32x4*)(tq + 4);
        f32x4 rw[8];
#pragma unroll
        for (int i = 0; i < 8; ++i) rw[i] = roww[(u.x1 & 0xFFFFF) + wr * 64 + fr + (i >> 2) * 128 + (i & 3) * 16];
#pragma unroll
        for (int ai = 0; ai < 2; ++ai)
#pragma unroll
            for (int m = 0; m < 4; ++m) { const int prow = prow0 + ai * 128 + m * 16; const f32x4 w4 = rw[ai * 4 + m]; const float w = which ? w4[1] : w4[0], sa = w4[2];
                const float nsa = -sa * LOG2E, rc = sa * sa * w;
                u32x2 pk;
#pragma unroll
                for (int n = 0; n < 2; ++n) { const f32x4 Gp = acc[ai][0][m][n] * (n ? sg1 : sg0), Up = acc[ai][1][m][n] * (n ? ut1 : ut0);
                    const f32x4 P = (Gp * Up) * rc, ar = Gp * nsa; f32x4 den;
#pragma unroll
                    for (int e = 0; e < 4; ++e) den[e] = __builtin_amdgcn_exp2f(ar[e]);
                    den = den + 1.0f;
#pragma unroll
                    for (int e = 0; e < 4; ++e) den[e] = __builtin_amdgcn_rcpf(den[e]);
                    const f32x4 o = P * den;
                    const unsigned q = cvt_fp8x4(__builtin_amdgcn_fmed3f(o[0], -448.0f, 448.0f), __builtin_amdgcn_fmed3f(o[1], -448.0f, 448.0f), __builtin_amdgcn_fmed3f(o[2], -448.0f, 448.0f), __builtin_amdgcn_fmed3f(o[3], -448.0f, 448.0f));
                    if (n) pk.y = q; else pk.x = q; }
                *(u32x2*)(HID + (size_t)prow * 1024 + col0) = pk; }
    }
};


__device__ __forceinline__ void transpose_job(const float* src, int sld, bf16_t* dst, int dld, LAS float* tile, int tid) {
    { const int c4 = (tid & 15) * 4, r = tid >> 4;
#pragma unroll
      for (int p = 0; p < 2; ++p) { const int rr = r + p * 32; const f32x4 v = *(const f32x4*)(src + (size_t)rr * sld + c4);
          tile[rr * 65 + c4 + 0] = v[0]; tile[rr * 65 + c4 + 1] = v[1]; tile[rr * 65 + c4 + 2] = v[2]; tile[rr * 65 + c4 + 3] = v[3]; } }
    __syncthreads();
    { const int n = tid >> 3, k8 = (tid & 7) * 8; float f[8];
#pragma unroll
      for (int j = 0; j < 8; ++j) f[j] = tile[(k8 + j) * 65 + n];
      u32x4 w; w.x = cvt_pk_bf16(f[0], f[1]); w.y = cvt_pk_bf16(f[2], f[3]); w.z = cvt_pk_bf16(f[4], f[5]); w.w = cvt_pk_bf16(f[6], f[7]);
      *(u32x4*)(dst + (size_t)n * dld + k8) = w; }
    __syncthreads();
}
constexpr int NCONV_LAYER = 176;
struct ConvJob { const float* src; bf16_t* dst; int sld, dld; };
__device__ __forceinline__ ConvJob conv_decode(KAp ap, int g, int tid) {
    const int ly = g >= NCONV_LAYER ? 1 : 0, J = g - ly * NCONV_LAYER, kg = tid & 7, cg = tid >> 3;
    unsigned char* ws = ap->ws; ConvJob c;
    { const int kt = J / 11, nt = J - kt * 11, ns = nt * 256 + 4 * cg; int nd = ns;
        if (ns >= 2304) { const int sx = ns >= 2560, j = ns - (sx ? 2560 : 2304); nd = 2304 + (j >> 7) * 256 + sx * 128 + (j & 127); }
        c.sld = 2816; c.dld = 1024;
        c.src = ap->in[7] + (size_t)ly * 1024 * 2816 + (size_t)(kt * 64 + 8 * kg) * 2816 + ns;
        c.dst = (bf16_t*)(ws + WS_WIN) + (size_t)ly * 2816 * 1024 + (size_t)nd * 1024 + kt * 64 + 8 * kg; }
    return c;
}
__device__ __forceinline__ void conv_load(const ConvJob& c, f32x4 (&v)[8]) {
#pragma unroll
    for (int i = 0; i < 8; ++i) v[i] = __builtin_nontemporal_load((const f32x4*)(c.src + (size_t)i * c.sld));
}
__device__ __forceinline__ void conv_store(const ConvJob& c, const f32x4 (&v)[8]) {
#pragma unroll
    for (int j = 0; j < 4; ++j) { u32x4 w; w.x = cvt_pk_bf16(v[0][j], v[1][j]); w.y = cvt_pk_bf16(v[2][j], v[3][j]); w.z = cvt_pk_bf16(v[4][j], v[5][j]); w.w = cvt_pk_bf16(v[6][j], v[7][j]);
        *(u32x4*)(c.dst + (size_t)j * c.dld) = w; }
}
constexpr int NGU8_LAYER = 512, NWIN8_LAYER = 88, Q8_WOUT0 = 2 * NGU8_LAYER, Q8_WIN0 = Q8_WOUT0 + 64;
__device__ __forceinline__ void q8_job(KAp ap, LAS unsigned char* lds, int g8, int tid) {
    unsigned char* ws = ap->ws;
    const int c4 = (tid & 7) * 4, r = tid >> 3;
    const float* src; unsigned char* dst; float* scp; int sld;
    if (g8 >= Q8_WOUT0 && g8 < Q8_WIN0) { const int q = g8 - Q8_WOUT0, ly = q >> 5, cb = q & 31; sld = 1024;
        src = ap->in[17] + (size_t)ly * 1048576 + cb * 32 + (size_t)(16 * r) * 1024 + c4;
        dst = ws + WS_WOUT + ((size_t)ly * 1024 + cb * 32 + c4) * 1024 + 16 * r; scp = (float*)(ws + WS_SWO) + (size_t)ly * 1024 + cb * 32; }
    else if (g8 < Q8_WIN0) { const int ly = g8 >= NGU8_LAYER ? 1 : 0, jidx = g8 - ly * NGU8_LAYER, up = jidx >> 8, e = (jidx >> 4) & 15, cb = jidx & 15, le = ly * 16 + e;
        const int n0 = cb * 32, row0 = (n0 >> 7) * 256 + up * 128 + (n0 & 127); sld = 512;
        src = ap->in[up ? 22 : 21] + (size_t)le * (1024 * 512) + cb * 32 + (size_t)(16 * r) * 512 + c4;
        dst = ws + WS_WGU + ((size_t)le * 1024 + row0 + c4) * 1024 + 16 * r; scp = (float*)(ws + WS_SGU) + (size_t)le * 1024 + row0; }
    else { const int q = g8 - Q8_WIN0, ly = q >= NWIN8_LAYER ? 1 : 0, cb = q - ly * NWIN8_LAYER; int n0 = cb * 32; sld = 2816;
        src = ap->in[7] + (size_t)ly * 1024 * 2816 + n0 + (size_t)(16 * r) * 2816 + c4;
        if (n0 >= 2304) { const int sx = n0 >= 2560, j = n0 - (sx ? 2560 : 2304); n0 = 2304 + (j >> 7) * 256 + sx * 128 + (j & 127); }
        dst = ws + WS_WIN + ((size_t)ly * 2816 + n0 + c4) * 1024 + 16 * r; scp = (float*)(ws + WS_SWIN) + (size_t)ly * 2816 + n0; }
    LAS float* red = (LAS float*)lds;
    LAS float* inv = (LAS float*)(lds + 1024);
    f32x4 v[16];
#pragma unroll
    for (int i = 0; i < 16; ++i) v[i] = __builtin_nontemporal_load((const f32x4*)(src + (size_t)i * sld));
    f32x4 mx = (f32x4){0.f, 0.f, 0.f, 0.f};
#pragma unroll
    for (int i = 0; i < 16; ++i) { mx[0] = fmaxf(mx[0], fabsf(v[i][0])); mx[1] = fmaxf(mx[1], fabsf(v[i][1])); mx[2] = fmaxf(mx[2], fabsf(v[i][2])); mx[3] = fmaxf(mx[3], fabsf(v[i][3])); }
#pragma unroll
    for (int o = 8; o < 64; o <<= 1) { mx[0] = fmaxf(mx[0], __shfl_xor(mx[0], o)); mx[1] = fmaxf(mx[1], __shfl_xor(mx[1], o)); mx[2] = fmaxf(mx[2], __shfl_xor(mx[2], o)); mx[3] = fmaxf(mx[3], __shfl_xor(mx[3], o)); }
    __syncthreads();
    if ((tid & 63) < 8) *(LAS f32x4*)(red + (tid >> 6) * 32 + c4) = mx;
    __syncthreads();
    if (tid < 32) { float m = 0.f;
#pragma unroll
        for (int w = 0; w < 8; ++w) m = fmaxf(m, red[w * 32 + tid]);
        const float sc = m > 0.f ? m * (1.0f / FP8_TOP) : 1.0f; scp[tid] = sc; inv[tid] = 1.0f / sc; }
    __syncthreads();
    const f32x4 iv = *(const LAS f32x4*)(inv + c4);
#pragma unroll
    for (int j = 0; j < 4; ++j) { u32x4 w;
        w.x = cvt_fp8x4(v[0][j] * iv[j], v[1][j] * iv[j], v[2][j] * iv[j], v[3][j] * iv[j]); w.y = cvt_fp8x4(v[4][j] * iv[j], v[5][j] * iv[j], v[6][j] * iv[j], v[7][j] * iv[j]);
        w.z = cvt_fp8x4(v[8][j] * iv[j], v[9][j] * iv[j], v[10][j] * iv[j], v[11][j] * iv[j]); w.w = cvt_fp8x4(v[12][j] * iv[j], v[13][j] * iv[j], v[14][j] * iv[j], v[15][j] * iv[j]);
        *(u32x4*)(dst + (size_t)j * 1024) = w; }
}
constexpr int NGD8_LAYER = 256;
__device__ __forceinline__ void q8d_job(KAp ap, LAS unsigned char* lds, int gd, int tid) {
    unsigned char* ws = ap->ws;
    const int le = gd >> 4, kb = gd & 15, c = tid & 255, kh = tid >> 8;
    const float* src = ap->in[23] + (size_t)le * (512 * 1024) + (size_t)(kb * 32 + kh * 16) * 1024 + 4 * c;
    unsigned char* dst = ws + WS_WD + (size_t)le * (1024 * 512) + (size_t)(4 * c) * 512 + kb * 32 + kh * 16;
    float* tp = (float*)(ws + WS_TD) + (size_t)le * 512 + kb * 32;
    LAS float* red = (LAS float*)lds;
    LAS float* tf = (LAS float*)(lds + 1024);
    f32x4 v[16];
#pragma unroll
    for (int i = 0; i < 16; ++i) v[i] = __builtin_nontemporal_load((const f32x4*)(src + (size_t)i * 1024));
    float mr[16];
#pragma unroll
    for (int i = 0; i < 16; ++i) mr[i] = wave_max(fmaxf(fmaxf(fabsf(v[i][0]), fabsf(v[i][1])), fmaxf(fabsf(v[i][2]), fabsf(v[i][3]))));
    __syncthreads();
    if ((tid & 63) == 0) {
#pragma unroll
        for (int i = 0; i < 16; i += 4) *(LAS f32x4*)(red + (tid >> 6) * 16 + i) = (f32x4){mr[i], mr[i + 1], mr[i + 2], mr[i + 3]}; }
    __syncthreads();
    if (tid < 32) { const int h = tid >> 4, i = tid & 15; float m = 0.f;
#pragma unroll
        for (int w = 0; w < 4; ++w) m = fmaxf(m, red[(h * 4 + w) * 16 + i]);
        const float t = m > 0.f ? m : 1.0f; tp[tid] = t * HID_CH; tf[tid] = FP8_TOP / t; }
    __syncthreads();
    float f[16];
#pragma unroll
    for (int i = 0; i < 16; i += 4) { const f32x4 q = *(const LAS f32x4*)(tf + kh * 16 + i); f[i] = q[0]; f[i + 1] = q[1]; f[i + 2] = q[2]; f[i + 3] = q[3]; }
#pragma unroll
    for (int j = 0; j < 4; ++j) { u32x4 w;
        w.x = cvt_fp8x4(v[0][j] * f[0], v[1][j] * f[1], v[2][j] * f[2], v[3][j] * f[3]); w.y = cvt_fp8x4(v[4][j] * f[4], v[5][j] * f[5], v[6][j] * f[6], v[7][j] * f[7]);
        w.z = cvt_fp8x4(v[8][j] * f[8], v[9][j] * f[9], v[10][j] * f[10], v[11][j] * f[11]); w.w = cvt_fp8x4(v[12][j] * f[12], v[13][j] * f[13], v[14][j] * f[14], v[15][j] * f[15]);
        *(u32x4*)(dst + (size_t)j * 512) = w; }
}
__device__ __forceinline__ void convert_jobs(KAp ap, int jlo, int jhi, int rank, int nworkers, int tid) {
    for (int J = jlo + rank; J < jhi; J += 2 * nworkers) {
        const ConvJob c0 = conv_decode(ap, J, tid), c1 = conv_decode(ap, J + nworkers < jhi ? J + nworkers : J, tid);
        f32x4 v0[8], v1[8]; conv_load(c0, v0); conv_load(c1, v1); conv_store(c0, v0); conv_store(c1, v1); }
}
constexpr int CQ0 = 176, CQ1 = 2 * NCONV_LAYER;
constexpr int CH1 = 640, CH2 = 704;
constexpr int CD1 = 384;
__device__ __forceinline__ void convert_queue(KAp ap, LAS unsigned char* lds, int lo, int hi, int qi, int tid) {
    unsigned* ctr = (unsigned*)(ap->ws + WS_CTL) + CW_CQ + qi * 64;
    volatile LAS unsigned* slot = (volatile LAS unsigned*)(lds + LDS_MISC + 64);
    unsigned nxt = 0; if (tid == 0) nxt = atomicAdd(ctr, 2u);
    for (;;) {
        __syncthreads();
        if (tid == 0) slot[0] = nxt;
        __syncthreads();
        const int base = lo + (int)slot[0];
        if (base >= hi) break;
        if (tid == 0) nxt = atomicAdd(ctr, 2u);
        const ConvJob c0 = conv_decode(ap, base, tid), c1 = conv_decode(ap, base + 1 < hi ? base + 1 : base, tid);
        f32x4 v0[8], v1[8]; conv_load(c0, v0); conv_load(c1, v1); conv_store(c0, v0); conv_store(c1, v1);
    }
}
template <bool DOWN = false>
__device__ __forceinline__ void gu8_queue(KAp ap, LAS unsigned char* lds, int lo, int hi, int qi, int tid) {
    unsigned* ctr = (unsigned*)(ap->ws + WS_CTL) + CW_CQ + qi * 64;
    volatile LAS unsigned* slot = (volatile LAS unsigned*)(lds + LDS_MISC + 64);
    for (;;) {
        __syncthreads();
        if (tid == 0) slot[0] = atomicAdd(ctr, 1u);
        __syncthreads();
        const int j = lo + (int)slot[0];
        if (j >= hi) break;
        if (DOWN) q8d_job(ap, lds, j, tid); else q8_job(ap, lds, j, tid);
    }
}
__device__ __forceinline__ void p0_phase(KAp ap, LAS unsigned char* lds, int tid, int G, int blk) {
    unsigned char* ws = ap->ws;
    LAS float* cond = (LAS float*)lds;
    LAS float* red = (LAS float*)(lds + 69632);
    { f32x4 cv[9];
#pragma unroll
      for (int p = 0; p < 9; ++p) { const int i4 = tid + 512 * p, j4 = i4 < 4352 ? i4 : 4351; cv[p] = *(const f32x4*)(j4 < 4096 ? ap->in[1] + j4 * 4 : ap->in[3] + (j4 - 4096) * 4); }
      __builtin_amdgcn_sched_barrier(0);
#pragma unroll
      for (int p = 0; p < 9; ++p) { const int i4 = tid + 512 * p; if (i4 < 4352) { f32x4 v = cv[p]; v[0] *= sigmoidf_(v[0]); v[1] *= sigmoidf_(v[1]); v[2] *= sigmoidf_(v[2]); v[3] *= sigmoidf_(v[3]); *(LAS f32x4*)(cond + i4 * 4) = v; } } }
    __syncthreads();
    float* mod = (float*)(ws + WS_MOD);
    for (int job = blk; job < 256; job += G) {
        const int l = job >> 7, col0 = (job & 127) * 48;
        if (tid < 384) { const int col = tid % 48, ks = tid / 48; float acc[17];
#pragma unroll
            for (int r = 0; r < 17; ++r) acc[r] = 0.f;
            const float* wp = ap->in[4] + (size_t)l * 1024 * NMODC + (size_t)(ks * 128) * NMODC + col0 + col;
            float wc[16], wn[16];
#pragma unroll
            for (int j = 0; j < 16; ++j) wc[j] = wp[(size_t)j * NMODC];
#pragma nounroll
            for (int k0 = 0; k0 < 128; k0 += 16) {
                const int kn = k0 + 16 < 128 ? k0 + 16 : k0;
#pragma unroll
                for (int j = 0; j < 16; ++j) wn[j] = wp[(size_t)(kn + j) * NMODC];
                __builtin_amdgcn_sched_barrier(0);
#pragma unroll
                for (int j = 0; j < 16; ++j)
#pragma unroll
                    for (int r = 0; r < 17; ++r) acc[r] += cond[r * 1024 + ks * 128 + k0 + j] * wc[j];
                __builtin_amdgcn_sched_barrier(0);
#pragma unroll
                for (int j = 0; j < 16; ++j) wc[j] = wn[j];
            }
#pragma unroll
            for (int r = 0; r < 17; ++r) red[(ks * 17 + r) * 48 + col] = acc[r]; }
        __syncthreads();
        for (int i = tid; i < 17 * 48; i += 512) { const int r = i / 48, col = i % 48; float s = ap->in[5][l * NMODC + col0 + col];
#pragma unroll
            for (int ks = 0; ks < 8; ++ks) s += red[(ks * 17 + r) * 48 + col];
            mod[(size_t)(l * 17 + r) * NMODC + col0 + col] = s; }
        __syncthreads();
    }
    for (int j = blk; j < NWIN8_LAYER; j += G) q8_job(ap, lds, Q8_WIN0 + j, tid);
    __syncthreads();

    { bf16_t* rgw = (bf16_t*)(ws + WS_RGW); LAS float* tile = (LAS float*)lds;
      for (int m = blk; m < 32; m += G) transpose_job(ap->in[10] + (size_t)m * 4096, 64, rgw + (size_t)m * 4096, 64, tile, tid); }
}

__device__ __forceinline__ void route_decide(const float (&lg)[16], int& bucket, float& wlo, float& whi) {
    float mx = lg[0];
#pragma unroll
    for (int e = 1; e < 16; ++e) mx = fmaxf(mx, lg[e]);
    float p[16];
#pragma unroll
    for (int e = 0; e < 16; ++e) p[e] = __expf(lg[e] - mx);
    int gsel = 0; float gbest = -1.f;
#pragma unroll
    for (int g = 0; g < 4; ++g) { const float a0 = p[4 * g], a1 = p[4 * g + 1], a2 = p[4 * g + 2], a3 = p[4 * g + 3];
        const float h1 = fmaxf(a0, a1), l1 = fminf(a0, a1), h2 = fmaxf(a2, a3), l2 = fminf(a2, a3);
        const float top = fmaxf(h1, h2), sec = fmaxf(fminf(h1, h2), fmaxf(l1, l2));
        const float sc2 = top + sec; if (sc2 > gbest) { gbest = sc2; gsel = g; } }
    float q0 = 0.f, q1 = 0.f, q2 = 0.f, q3 = 0.f;
#pragma unroll
    for (int g = 0; g < 4; ++g) if (g == gsel) { q0 = p[4 * g]; q1 = p[4 * g + 1]; q2 = p[4 * g + 2]; q3 = p[4 * g + 3]; }
    int i1 = 0; float b1 = q0; if (q1 > b1) { b1 = q1; i1 = 1; } if (q2 > b1) { b1 = q2; i1 = 2; } if (q3 > b1) { b1 = q3; i1 = 3; }
    int i2 = -1; float b2 = -1.f;
    if (i1 != 0 && q0 > b2) { b2 = q0; i2 = 0; } if (i1 != 1 && q1 > b2) { b2 = q1; i2 = 1; } if (i1 != 2 && q2 > b2) { b2 = q2; i2 = 2; } if (i1 != 3 && q3 > b2) { b2 = q3; i2 = 3; }
    const int lo = i1 < i2 ? i1 : i2, hi = i1 < i2 ? i2 : i1;
    const float inv = 1.0f / (b1 + b2);
    wlo = (lo == i1 ? b1 : b2) * inv; whi = (hi == i1 ? b1 : b2) * inv;
    const int pidx = lo == 0 ? hi - 1 : (lo == 1 ? hi + 1 : 5);
    bucket = gsel * 6 + pidx;
}
struct RnArgs {
    const float* xl; const float* xc;
    const bf16_t* xs16; bf16_t* xd16;
    const bf16_t* Y; const float* gatev;
    const u32x4* tokinfo_prev; const unsigned* gcnt_prev;
    const float* gvec; const float* modl; bf16_t* H; float* outf;
    f32x4* rw;
    unsigned char* H8; float* HS;
    const float* wrt; const float* brt; unsigned* gcnt; u32x4* tokinfo;
    int gi, si, ntok;
};
template <int RES, bool ROUTER, bool FINAL, bool SRC16>
__device__ __forceinline__ void resnorm_phase(const RnArgs& A, LAS unsigned char* lds, int tid, int G, int blk) {
    const int wave = __builtin_amdgcn_readfirstlane(tid >> 6), lane = tid & 63;
    constexpr int HP_ = 1032;
    LAS bf16_t* hbuf = (LAS bf16_t*)lds;
    constexpr int B2 = 66560;
    LAS int* lcnt = (LAS int*)(lds + B2);
    LAS int* lbase = (LAS int*)(lds + B2 + 128);
    LAS int* tstp = (LAS int*)(lds + B2 + 256);
    LAS u32x4* tokbuf = (LAS u32x4*)(lds + B2 + 512);
    LAS float* part = (LAS float*)(lds + B2 + 4096);
    LAS float* mv = (LAS float*)(lds + B2 + 12288);
    const int ntok = A.ntok, chunk = (ntok + G - 1) / G, t0 = blk * chunk, t1 = (t0 + chunk < ntok) ? t0 + chunk : ntok;
    if (ROUTER) { if (tid < 32) lcnt[tid] = 0; }
    if (RES == 2) { if (tid < 64) { const int n = tid < NBUCK ? (int)((A.gcnt_prev[tid] + 255u) >> 8) : 0; int inc = n;
#pragma unroll
            for (int o = 1; o < 32; o <<= 1) { const int t = __shfl_up(inc, o); if (tid >= o) inc += t; }
            if (tid < NBUCK) tstp[tid] = inc - n; } }
    if (ROUTER || RES == 2) __syncthreads();
    f32x4 gv4[4];
#pragma unroll
    for (int j = 0; j < 4; ++j) gv4[j] = *(const f32x4*)(A.gvec + j * 256 + lane * 4);
    bf16x8 Bh[4], Bl[4];
    if (ROUTER) {
#pragma unroll
        for (int ks = 0; ks < 4; ++ks) { const float* wp = A.wrt + (size_t)(wave * 128 + ks * 32 + (lane >> 4) * 8) * 16 + (lane & 15);
            float f[8], g[8];
#pragma unroll
            for (int j = 0; j < 8; ++j) { f[j] = wp[j * 16]; g[j] = f[j] - bf_lo(cvt_pk_bf16(f[j], 0.f)); }
            union { u32x4 u; bf16x8 b; } h_, l_;
            h_.u.x = cvt_pk_bf16(f[0], f[1]); h_.u.y = cvt_pk_bf16(f[2], f[3]); h_.u.z = cvt_pk_bf16(f[4], f[5]); h_.u.w = cvt_pk_bf16(f[6], f[7]);
            l_.u.x = cvt_pk_bf16(g[0], g[1]); l_.u.y = cvt_pk_bf16(g[2], g[3]); l_.u.z = cvt_pk_bf16(g[4], g[5]); l_.u.w = cvt_pk_bf16(g[6], g[7]);
            Bh[ks] = h_.b; Bl[ks] = l_.b; }
    }
    float rb = 0.f; if (ROUTER) rb = A.brt[lane & 15];
    f32x4 xv[4], xn[4]; u32x2 yv[4], yn[4];
#define RN_LOAD(row, X, Yv) do { \
        if (SRC16) { const bf16_t* xp_ = A.xs16 + (size_t)(row) * D; _Pragma("unroll") for (int j = 0; j < 4; ++j) { const u32x2 w_ = *(const u32x2*)(xp_ + j * 256 + lane * 4); X[j] = (f32x4){bf_lo(w_.x), bf_hi(w_.x), bf_lo(w_.y), bf_hi(w_.y)}; } } \
        else { const float* xp_ = (row) < NLAT ? A.xl + (size_t)(row) * D : A.xc + (size_t)((row) - NLAT) * D; \
            _Pragma("unroll") for (int j = 0; j < 4; ++j) X[j] = *(const f32x4*)(xp_ + j * 256 + lane * 4); } \
        if (RES == 1) { const bf16_t* yp_ = A.Y + (size_t)(row) * D; _Pragma("unroll") for (int j = 0; j < 4; ++j) Yv[j] = *(const u32x2*)(yp_ + j * 256 + lane * 4); } \
        if (RES == 2) { const u32x4 ti_ = tin; const bf16_t* yp_ = A.Y + (size_t)(tstp[ti_.x] * 256 + (int)ti_.y) * D; \
            _Pragma("unroll") for (int j = 0; j < 4; ++j) Yv[j] = *(const u32x2*)(yp_ + j * 256 + lane * 4); \
            tin = A.tokinfo_prev[(row) + 8 < s1 ? (row) + 8 : s1 - 1]; } } while (0)
    for (int s0 = t0; s0 < t1; ) {
        const int mrow = s0 < NLAT ? (s0 >> 11) : 16;
        const int bnd = s0 < NLAT ? ((s0 >> 11) + 1) << 11 : ntok, s1 = bnd < t1 ? bnd : t1;
        __syncthreads();
        for (int i = tid; i < 768; i += 512) { const int a = i >> 8, k4 = (i & 255) * 4;
            const float* src = (a == 0) ? A.gatev + (size_t)mrow * NMODC + A.gi * D : A.modl + (size_t)mrow * NMODC + (A.si + a - 1) * D;
            f32x4 w = (f32x4){0.f, 0.f, 0.f, 0.f}; if ((a == 0) ? (RES != 0) : !FINAL) w = *(const f32x4*)(src + k4);
            *(LAS f32x4*)(mv + a * 1024 + k4) = w; }
        __syncthreads();
        const int niter = (s1 - s0 + 7) >> 3;
        int row = s0 + wave;
        u32x4 tin = (u32x4){0u, 0u, 0u, 0u}; if (RES == 2 && row < s1) tin = A.tokinfo_prev[row];
        if (row < s1) RN_LOAD(row, xv, yv);
        for (int it = 0; it < niter; ++it, row += 8) {
            if (row < s1) {
                const int nrow = row + 8 < s1 ? row + 8 : s1 - 1;
                RN_LOAD(nrow, xn, yn);
                f32x4 v[4]; float ss = 0.f;
#pragma unroll
                for (int j = 0; j < 4; ++j) { v[j] = xv[j];
                    if (RES != 0) { const f32x4 gg = *(const LAS f32x4*)(mv + j * 256 + lane * 4);
                        v[j][0] += gg[0] * bf_lo(yv[j].x); v[j][1] += gg[1] * bf_hi(yv[j].x); v[j][2] += gg[2] * bf_lo(yv[j].y); v[j][3] += gg[3] * bf_hi(yv[j].y);
                        if (!FINAL) { u32x2 w; w.x = cvt_pk_bf16(v[j][0], v[j][1]); w.y = cvt_pk_bf16(v[j][2], v[j][3]); *(u32x2*)(A.xd16 + (size_t)row * D + j * 256 + lane * 4) = w; } }
                    ss += v[j][0] * v[j][0] + v[j][1] * v[j][1] + v[j][2] * v[j][2] + v[j][3] * v[j][3]; }
                ss = wave_sum(ss);
                const float rstd = rsqrtf(ss * (1.0f / D) + EPSN);
                if (FINAL) {
#pragma unroll
                    for (int j = 0; j < 4; ++j) *(f32x4*)(A.outf + (size_t)row * D + j * 256 + lane * 4) = v[j] * rstd * gv4[j];
                } else {
#pragma unroll
                    for (int j = 0; j < 4; ++j) { const int k = j * 256 + lane * 4; const f32x4 sh = *(const LAS f32x4*)(mv + 1024 + k), sc = *(const LAS f32x4*)(mv + 2048 + k);
                        v[j] = (v[j] * rstd * gv4[j]) * (1.0f + sc) + sh;
                        }
                    {
                        float am = 0.f;
#pragma unroll
                        for (int j = 0; j < 4; ++j) am = fmaxf(am, fmaxf(fmaxf(fabsf(v[j][0]), fabsf(v[j][1])), fmaxf(fabsf(v[j][2]), fabsf(v[j][3]))));
                        am = wave_max(am);
                        const float sa = am > 0.f ? am * (1.0f / FP8_TOP) : 1.0f, ia = 1.0f / sa;
                        LAS bf16_t* hr = hbuf + ((it & 1) * 8 + wave) * HP_ + lane * 4;
#pragma unroll
                        for (int j = 0; j < 4; ++j) { *(unsigned*)(A.H8 + (size_t)row * D + j * 256 + lane * 4) = cvt_fp8x4(v[j][0] * ia, v[j][1] * ia, v[j][2] * ia, v[j][3] * ia);
                          if (ROUTER) {
                            u32x2 hi; hi.x = cvt_pk_bf16(v[j][0], v[j][1]); hi.y = cvt_pk_bf16(v[j][2], v[j][3]);
                            u32x2 lo; lo.x = cvt_pk_bf16(v[j][0] - bf_lo(hi.x), v[j][1] - bf_hi(hi.x)); lo.y = cvt_pk_bf16(v[j][2] - bf_lo(hi.y), v[j][3] - bf_hi(hi.y));
                            *(LAS u32x2*)(hr + j * 256) = hi; *(LAS u32x2*)(hr + 16 * HP_ + j * 256) = lo; } }
                        if (lane == 0) A.HS[row] = sa;
                    }
                }
#pragma unroll
                for (int j = 0; j < 4; ++j) { xv[j] = xn[j]; yv[j] = yn[j]; }
            }
            if (ROUTER && ((it & 1) || it == niter - 1)) {
                __syncthreads();
                { const int n16 = lane & 15, kg = lane >> 4; f32x4 acc = (f32x4){0.f, 0.f, 0.f, 0.f};
#pragma unroll
                  for (int ks = 0; ks < 4; ++ks) { const LAS bf16_t* ap = hbuf + n16 * HP_ + wave * 128 + ks * 32 + kg * 8;
                      const bf16x8 ah = *(const LAS bf16x8*)ap, al = *(const LAS bf16x8*)(ap + 16 * HP_);
                      acc = __builtin_amdgcn_mfma_f32_16x16x32_bf16(ah, Bh[ks], acc, 0, 0, 0);
                      acc = __builtin_amdgcn_mfma_f32_16x16x32_bf16(ah, Bl[ks], acc, 0, 0, 0);
                      acc = __builtin_amdgcn_mfma_f32_16x16x32_bf16(al, Bh[ks], acc, 0, 0, 0); }
#pragma unroll
                  for (int e = 0; e < 4; ++e) part[(wave * 16 + kg * 4 + e) * 16 + n16] = acc[e]; }
                __syncthreads();
                const int rb0 = s0 + (it >> 1) * 16;
                if (tid < 256) {
                    const int r16 = tid >> 4, x = tid & 15; float lgx = rb;
#pragma unroll
                    for (int w = 0; w < 8; ++w) lgx += part[(w * 16 + r16) * 16 + x];
                    float lg[16];
#pragma unroll
                    for (int e = 0; e < 16; ++e) lg[e] = __shfl(lgx, (lane & 48) + e);
                    if (rb0 + r16 < s1) { int bk; float wl_, wh_; route_decide(lg, bk, wl_, wh_);
                        if (x == 0) { const int ls = atomicAdd((int*)(lcnt + bk), 1); tokbuf[rb0 + r16 - t0] = (u32x4){(unsigned)bk, (unsigned)ls, __float_as_uint(wl_), __float_as_uint(wh_)}; } }
                }
            }
        }
        s0 = s1;
    }
#undef RN_LOAD
    if (ROUTER) {
        __syncthreads();
        if (tid < NBUCK) { const int n = lcnt[tid]; lbase[tid] = n > 0 ? (int)atomicAdd(A.gcnt + tid, (unsigned)n) : 0; }
        __syncthreads();
        for (int i = tid; i < t1 - t0; i += 512) { u32x4 t = tokbuf[i]; t.y += (unsigned)lbase[t.x]; A.tokinfo[t0 + i] = t;
            A.rw[(size_t)t.x * MT + t.y] = (f32x4){__uint_as_float(t.z), __uint_as_float(t.w), A.HS[t0 + i], __int_as_float(t0 + i)}; }
    }
}

__device__ __forceinline__ void moe_offsets(const unsigned* gcnt, LAS int* tst  , int tid) {
    if (tid < 64) {
        const int n = tid < NBUCK ? (int)((gcnt[tid] + 255u) >> 8) : 0; int inc = n;
#pragma unroll
        for (int o = 1; o < 32; o <<= 1) { const int t = __shfl_up(inc, o); if (tid >= o) inc += t; }
        if (tid < NBUCK) { tst[tid] = inc - n; tst[208 + tid] = (int)gcnt[tid]; } if (tid == NBUCK - 1) tst[NBUCK] = inc; }
    __syncthreads();
    if (tid < MPERM / 256) { int bk = 0; for (int b = 1; b < NBUCK; ++b) bk += (tst[b] <= tid) ? 1 : 0; tst[32 + tid] = bk; }
    __syncthreads();
}
__device__ __forceinline__ void permute_phase(const unsigned char* H8, const float* HS, unsigned char* HP8, const u32x4* tokinfo, const unsigned* gcnt, f32x4* roww, int ntok, LAS int* tst, int tid, int G, int blk) {
    const int wave = __builtin_amdgcn_readfirstlane(tid >> 6), lane = tid & 63;
    moe_offsets(gcnt, tst, tid);
    const int stride = G * 8; int row = blk * 8 + wave;
    u32x4 ti = (u32x4){0u, 0u, 0u, 0u}, tin = ti, a0 = ti; float hs = 0.f;
    if (row < ntok) { ti = tokinfo[row]; a0 = ((const u32x4*)(H8 + (size_t)row * D))[lane]; hs = HS[row]; }
    if (row + stride < ntok) tin = tokinfo[row + stride];
    for (; row < ntok; row += stride) {
        const u32x4 tc = ti, c0 = a0; const float hc = hs; ti = tin;
        { const int r1 = row + stride < ntok ? row + stride : ntok - 1, r2 = row + 2 * stride < ntok ? row + 2 * stride : ntok - 1;
          a0 = ((const u32x4*)(H8 + (size_t)r1 * D))[lane]; hs = HS[r1]; tin = tokinfo[r2]; }
        const int dest = tst[tc.x] * 256 + (int)tc.y;
        ((u32x4*)(HP8 + (size_t)dest * D))[lane] = c0;
        if (lane == 0) roww[dest] = (f32x4){__uint_as_float(tc.z), __uint_as_float(tc.w), hc, 0.f};
    }
}

struct AttnKV { bf16x8 k[2][2]; bf16x8 v[4]; };
__device__ __forceinline__ void attn_load(AttnKV& kv, const bf16_t* U, const bf16_t* VT, int tokbase, int h, unsigned klo, unsigned vlo) {
    const bf16_t* kb = U + (size_t)tokbase * UW + UK + h * 64;
    kv.k[0][0] = *(const bf16x8*)(kb + klo); kv.k[0][1] = *(const bf16x8*)(kb + 32 + klo);
    kv.k[1][0] = *(const bf16x8*)(kb + 4 * UW + klo); kv.k[1][1] = *(const bf16x8*)(kb + 4 * UW + 32 + klo);
    const bf16_t* vb = VT + (size_t)(h * 64) * MT + (size_t)tokbase * 2;
#pragma unroll
    for (int db = 0; db < 4; ++db) kv.v[db] = *(const bf16x8*)(vb + (size_t)db * 16 * MT + vlo);
}
template <bool LOCAL, int HALF>
__device__ __forceinline__ void attn_step(const AttnKV& kv, const bf16x8 q0, const bf16x8 q1, f32x4 (&O)[4], float& m, float& l, const bool first, const LAS float* bptr, const LAS f32x4* mptr) {
    const f32x4 z = (f32x4){0.f, 0.f, 0.f, 0.f};
    f32x4 s0 = __builtin_amdgcn_mfma_f32_16x16x32_bf16(kv.k[0][0], q0, z, 0, 0, 0); s0 = __builtin_amdgcn_mfma_f32_16x16x32_bf16(kv.k[0][1], q1, s0, 0, 0, 0);
    f32x4 s1 = __builtin_amdgcn_mfma_f32_16x16x32_bf16(kv.k[1][0], q0, z, 0, 0, 0); s1 = __builtin_amdgcn_mfma_f32_16x16x32_bf16(kv.k[1][1], q1, s1, 0, 0, 0);
    float t[8]; const float nm = -m;
#pragma unroll
    for (int e = 0; e < 8; ++e) { const float sv = e < 4 ? s0[e & 3] : s1[e & 3];
        t[e] = __builtin_fmaf(sv, 0.125f * LOG2E, nm);
        if (LOCAL) t[e] = (t[e] + bptr[HALF * 32 + (e >> 2) * 4 + (e & 3)]) + ((const LAS float*)mptr)[(e >> 2) * 256 + (e & 3)]; }
    float cm = fmaxf(fmaxf(fmaxf(t[0], t[1]), fmaxf(t[2], t[3])), fmaxf(fmaxf(t[4], t[5]), fmaxf(t[6], t[7])));
    if (first || __builtin_amdgcn_ballot_w64(cm > 8.0f) != 0ull) {
        cm = fmaxf(cm, __shfl_xor(cm, 16)); cm = fmaxf(cm, __shfl_xor(cm, 32));
        const float d = first ? cm : fmaxf(cm, 0.f), alpha = first ? 1.0f : __builtin_amdgcn_exp2f(-d);
        m += d; l *= alpha;
#pragma unroll
        for (int e = 0; e < 8; ++e) t[e] -= d;
#pragma unroll
        for (int db = 0; db < 4; ++db) O[db] *= alpha;
    }
    float ps = 0.f;
#pragma unroll
    for (int e = 0; e < 8; ++e) { t[e] = __builtin_amdgcn_exp2f(t[e]); ps += t[e]; }
    l += ps;
    union { u32x4 u; bf16x8 b; } pk;
    pk.u.x = cvt_pk_bf16(t[0], t[1]); pk.u.y = cvt_pk_bf16(t[2], t[3]); pk.u.z = cvt_pk_bf16(t[4], t[5]); pk.u.w = cvt_pk_bf16(t[6], t[7]);
#pragma unroll
    for (int db = 0; db < 4; ++db) O[db] = __builtin_amdgcn_mfma_f32_16x16x32_bf16(kv.v[db], pk.b, O[db], 0, 0, 0);
}
constexpr int ATT_RPB_OFF = 1024;
constexpr int ATT_MASK_OFF = 16384;
constexpr int ATT_Q_OFF = 28672;
__device__ __forceinline__ void attn_row(const bf16_t* U, const bf16_t* VT, bf16_t* YNA, LAS unsigned char* lds, int qtok0, int b, int r, int nloc, int h, int lane) {
    const int qi = lane & 15, kg = lane >> 4;
    LAS bf16x8* qs = (LAS bf16x8*)(lds + ATT_Q_OFF + h * 8192) + lane;
    { bf16x8 qv[8];
#pragma unroll
      for (int qb = 0; qb < 4; ++qb) { const bf16_t* qp = U + (size_t)(qtok0 + qb * 16 + qi) * UW + UQ + h * 64 + kg * 8; qv[qb * 2] = *(const bf16x8*)qp; qv[qb * 2 + 1] = *(const bf16x8*)(qp + 32); }
      __builtin_amdgcn_sched_barrier(0);
#pragma unroll
      for (int i = 0; i < 8; ++i) qs[i * 64] = qv[i]; }
    f32x4 O[4][4]; float m[4], l[4];
#pragma unroll
    for (int qb = 0; qb < 4; ++qb) { m[qb] = 0.f; l[qb] = 0.f;
#pragma unroll
        for (int db = 0; db < 4; ++db) O[qb][db] = (f32x4){0.f, 0.f, 0.f, 0.f}; }
    const int r0 = min(max(r - 4, 0), NROWS - 8);
    asm volatile("" : "+s"(nloc));
    const int nchunk = 8 + 2 * nloc, cbase = NLAT + b * CTXL, lbase = b * SEQ + r0 * GW;
    const LAS f32x4* mtab = (const LAS f32x4*)(lds + ATT_MASK_OFF) + lane;
    const LAS float* btab = (const LAS float*)(lds + ATT_RPB_OFF) + (kg * 8 - qi + 15);
#define ATT_TOKBASE(c) ((c) < 8 ? cbase + 32 * (c) : lbase + 32 * ((c) - 8))
    AttnKV A, B;
    const unsigned klo = (unsigned)((8 * (qi >> 2) + (qi & 3)) * UW + kg * 8), vlo = (unsigned)((qi >> 1) * 2 * MT + (qi & 1) * 32 + kg * 8);
    attn_load(A, U, VT, ATT_TOKBASE(0), h, klo, vlo);
    for (int c = 0; c < nchunk; c += 2) {
        attn_load(B, U, VT, ATT_TOKBASE(c + 1), h, klo, vlo);
        if (c < 8) {
#pragma unroll
            for (int qb = 0; qb < 4; ++qb) attn_step<false, 0>(A, qs[(qb * 2) * 64], qs[(qb * 2 + 1) * 64], O[qb], m[qb], l[qb], c == 0, btab, mtab);
        } else { const int bo = (h * 15 + (r0 + ((c - 8) >> 1) - r + 7)) * 31;
#pragma unroll
            for (int qb = 0; qb < 3; ++qb) attn_step<true, 0>(A, qs[(qb * 2) * 64], qs[(qb * 2 + 1) * 64], O[qb], m[qb], l[qb], false, btab + (bo - 16 * qb), mtab + qb * 128);
        }
        { const int cn = c + 2 < nchunk ? c + 2 : c; attn_load(A, U, VT, ATT_TOKBASE(cn), h, klo, vlo); }
        if (c < 8) {
#pragma unroll
            for (int qb = 0; qb < 4; ++qb) attn_step<false, 0>(B, qs[(qb * 2) * 64], qs[(qb * 2 + 1) * 64], O[qb], m[qb], l[qb], false, btab, mtab);
        } else { const int bo = (h * 15 + (r0 + ((c - 8) >> 1) - r + 7)) * 31;
#pragma unroll
            for (int qb = 1; qb < 4; ++qb) attn_step<true, 1>(B, qs[(qb * 2) * 64], qs[(qb * 2 + 1) * 64], O[qb], m[qb], l[qb], false, btab + (bo - 16 * qb), mtab + (3 + qb - 1) * 128);
        }
    }
#undef ATT_TOKBASE
#pragma unroll
    for (int qb = 0; qb < 4; ++qb) { float ls = l[qb]; ls += __shfl_xor(ls, 16); ls += __shfl_xor(ls, 32); const float inv = 1.0f / ls;
        bf16_t* yp = YNA + (size_t)(qtok0 + qb * 16 + qi) * 512 + h * 64 + kg * 4;
#pragma unroll
        for (int db = 0; db < 4; ++db) { u32x2 w; w.x = cvt_pk_bf16(O[qb][db][0] * inv, O[qb][db][1] * inv); w.y = cvt_pk_bf16(O[qb][db][2] * inv, O[qb][db][3] * inv); *(u32x2*)(yp + db * 16) = w; } }
}

__device__ __forceinline__ void lru_unit(KAp ap, int l, int tile, int hd, int dmask, LAS unsigned char* lds, int tid) {
    unsigned char* ws = ap->ws;
    const bf16_t* U = (const bf16_t*)(ws + WS_U);
    const int wave = __builtin_amdgcn_readfirstlane(tid >> 6), lane = tid & 63, n16 = lane & 15, kg = lane >> 4;
    LAS bf16_t* rxs = (LAS bf16_t*)(lds);
    LAS bf16_t* wl = (LAS bf16_t*)(lds + 36864);
    LAS float* cst = (LAS float*)(lds + 36864 + 18432);
    LAS float* wtot = (LAS float*)(lds + 36864 + 18432 + 1024);
    LAS unsigned* otile = (LAS unsigned*)(lds + 61440);
    const int pos0 = tile < 128 ? (tile & 7) * 256 : 0, seglen = tile < 128 ? SEQ : CTXL;
    __syncthreads();
    { const int c8 = (tid & 7) * 8, t0 = tid >> 3;
      const float* cw = ap->in[8] + (size_t)l * 4 * 256 + hd * 64 + c8; const float* cb = ap->in[9] + (size_t)l * 256 + hd * 64 + c8;
      u32x4 xv[4][4];
#pragma unroll
      for (int p = 0; p < 4; ++p)
#pragma unroll
          for (int k = 0; k < 4; ++k) { const int tt = t0 + 64 * p - 2 + k, pos = pos0 + tt; const bool in = pos >= 0 && pos < seglen;
              xv[p][k] = *(const u32x4*)(U + (size_t)(tile * 256 + (in ? tt : t0)) * UW + URX + hd * 64 + c8); }
      f32x4 wk[4][2], bv[2];
#pragma unroll
      for (int k = 0; k < 4; ++k) { wk[k][0] = *(const f32x4*)(cw + k * 256); wk[k][1] = *(const f32x4*)(cw + k * 256 + 4); }
      bv[0] = *(const f32x4*)cb; bv[1] = *(const f32x4*)(cb + 4);
      __builtin_amdgcn_sched_barrier(0);
#pragma unroll
      for (int p = 0; p < 4; ++p)
#pragma unroll
          for (int k = 0; k < 4; ++k) { const int pos = pos0 + t0 + 64 * p - 2 + k; if (!(pos >= 0 && pos < seglen)) xv[p][k] = (u32x4){0u, 0u, 0u, 0u}; }
#pragma unroll
      for (int p = 0; p < 4; ++p) { const int t = t0 + 64 * p; float acc[8] = {bv[0][0], bv[0][1], bv[0][2], bv[0][3], bv[1][0], bv[1][1], bv[1][2], bv[1][3]};
#pragma unroll
          for (int k = 0; k < 4; ++k) { const u32x4 v = xv[p][k]; const f32x4 w0 = wk[k][0], w1 = wk[k][1];
              acc[0] += w0[0] * bf_lo(v.x); acc[1] += w0[1] * bf_hi(v.x); acc[2] += w0[2] * bf_lo(v.y); acc[3] += w0[3] * bf_hi(v.y);
              acc[4] += w1[0] * bf_lo(v.z); acc[5] += w1[1] * bf_hi(v.z); acc[6] += w1[2] * bf_lo(v.w); acc[7] += w1[3] * bf_hi(v.w); }
          u32x4 o; o.x = cvt_pk_bf16(acc[0], acc[1]); o.y = cvt_pk_bf16(acc[2], acc[3]); o.z = cvt_pk_bf16(acc[4], acc[5]); o.w = cvt_pk_bf16(acc[6], acc[7]);
          *(LAS u32x4*)(rxs + t * 72 + c8) = o; } }
    for (int d = 0; d < 2; ++d) {
        if (!((dmask >> d) & 1)) continue;
        __syncthreads();
        { const bf16_t* rgw = (const bf16_t*)(ws + WS_RGW);
          u32x4 wv[2]; float c0 = 0.f, c1 = 0.f, lam = 0.f;
#pragma unroll
          for (int p = 0; p < 2; ++p) { const int item = tid + 512 * p, g = item >> 9, n = (item >> 3) & 63, c8 = (item & 7) * 8;
              wv[p] = *(const u32x4*)(rgw + (size_t)((((l * 2 + d) * 2 + g) * 4 + hd) * 64 + n) * 64 + c8); }
          if (tid < 64) { const int c = hd * 64 + tid; const float* rgb = ap->in[11];
              c0 = rgb[((l * 2 + d) * 2 + 0) * 256 + c]; c1 = rgb[((l * 2 + d) * 2 + 1) * 256 + c]; lam = ap->in[12][(l * 2 + d) * 256 + c]; }
          __builtin_amdgcn_sched_barrier(0);
#pragma unroll
          for (int p = 0; p < 2; ++p) { const int item = tid + 512 * p, g = item >> 9, n = (item >> 3) & 63, c8 = (item & 7) * 8; *(LAS u32x4*)(wl + (g * 64 + n) * 72 + c8) = wv[p]; }
          if (tid < 64) { cst[tid] = c0; cst[64 + tid] = c1; const float z = -lam; cst[128 + tid] = fmaxf(z, 0.f) + log1pf(__expf(-fabsf(z))); } }
        __syncthreads();
        f32x4 A_[2][4], H_[2][4];
        {
            bf16x8 af[2][2];
#pragma unroll
            for (int mb = 0; mb < 2; ++mb)
#pragma unroll
                for (int kc = 0; kc < 2; ++kc) af[mb][kc] = *(const LAS bf16x8*)(rxs + (wave * 32 + mb * 16 + n16) * 72 + kc * 32 + kg * 8);
#pragma unroll
            for (int nb = 0; nb < 4; ++nb) {
                f32x4 pr[2][2];
#pragma unroll
                for (int g = 0; g < 2; ++g) {
                    const bf16x8 b0 = *(const LAS bf16x8*)(wl + (g * 64 + nb * 16 + n16) * 72 + kg * 8), b1 = *(const LAS bf16x8*)(wl + (g * 64 + nb * 16 + n16) * 72 + 32 + kg * 8);
#pragma unroll
                    for (int mb = 0; mb < 2; ++mb) { f32x4 z = (f32x4){0.f, 0.f, 0.f, 0.f};
                        z = __builtin_amdgcn_mfma_f32_16x16x32_bf16(af[mb][0], b0, z, 0, 0, 0);
                        pr[g][mb] = __builtin_amdgcn_mfma_f32_16x16x32_bf16(af[mb][1], b1, z, 0, 0, 0); }
                }
                const int c = nb * 16 + n16; const float br = cst[c], bi = cst[64 + c], sp = cst[128 + c];
#pragma unroll
                for (int mb = 0; mb < 2; ++mb)
#pragma unroll
                    for (int e = 0; e < 4; ++e) { const int tok = wave * 32 + mb * 16 + kg * 4 + e; const float xr = bf2f(rxs[tok * 72 + c]);
                        const float rg = sigmoidf_(pr[0][mb][e] + br), ig = sigmoidf_(pr[1][mb][e] + bi);
                        const float la = -8.0f * rg * sp; const float av = __expf(la);
                        A_[mb][nb][e] = av; H_[mb][nb][e] = __builtin_amdgcn_sqrtf(fmaxf(1.0f - av * av, 0.f)) * (ig * xr); }
            }
        }
        const bool rev = d != 0;
#pragma unroll
        for (int nb = 0; nb < 4; ++nb) {
            float tA[2], tH[2];
#pragma unroll
            for (int mb = 0; mb < 2; ++mb) {
                f32x4 av = A_[mb][nb], bv = H_[mb][nb]; f32x4 cA, cH;
                if (!rev) { cA[0] = av[0]; cH[0] = bv[0];
#pragma unroll
                    for (int e = 1; e < 4; ++e) { cH[e] = av[e] * cH[e - 1] + bv[e]; cA[e] = cA[e - 1] * av[e]; } }
                else { cA[3] = av[3]; cH[3] = bv[3];
#pragma unroll
                    for (int e = 2; e >= 0; --e) { cH[e] = av[e] * cH[e + 1] + bv[e]; cA[e] = cA[e + 1] * av[e]; } }
                float gA = rev ? cA[0] : cA[3], gH = rev ? cH[0] : cH[3];
                { const float pA = __shfl(gA, rev ? lane + 16 : lane - 16), pH = __shfl(gH, rev ? lane + 16 : lane - 16);
                  const bool use = rev ? (kg <= 2) : (kg >= 1); if (use) { gH = gA * pH + gH; gA = pA * gA; } }
                { const float pA = __shfl(gA, rev ? lane + 32 : lane - 32), pH = __shfl(gH, rev ? lane + 32 : lane - 32);
                  const bool use = rev ? (kg <= 1) : (kg >= 2); if (use) { gH = gA * pH + gH; gA = pA * gA; } }
                float xA = __shfl(gA, rev ? lane + 16 : lane - 16), xH = __shfl(gH, rev ? lane + 16 : lane - 16);
                const bool first = rev ? (kg == 3) : (kg == 0); if (first) { xA = 1.f; xH = 0.f; }
#pragma unroll
                for (int e = 0; e < 4; ++e) { cH[e] = cA[e] * xH + cH[e]; cA[e] = cA[e] * xA; }
                tA[mb] = __shfl(gA, rev ? n16 : n16 + 48); tH[mb] = __shfl(gH, rev ? n16 : n16 + 48);
                A_[mb][nb] = cA; H_[mb][nb] = cH;
            }
            const float pA = rev ? tA[1] : tA[0], pH = rev ? tH[1] : tH[0];
#pragma unroll
            for (int e = 0; e < 4; ++e) { const float a0 = A_[0][nb][e], h0 = H_[0][nb][e], a1 = A_[1][nb][e], h1 = H_[1][nb][e];
                H_[0][nb][e] = rev ? a0 * pH + h0 : h0; A_[0][nb][e] = rev ? a0 * pA : a0;
                H_[1][nb][e] = rev ? h1 : a1 * pH + h1; A_[1][nb][e] = rev ? a1 : a1 * pA; }
            const float wA = tA[0] * tA[1], wH = rev ? (tA[0] * tH[1] + tH[0]) : (tA[1] * tH[0] + tH[1]);
            if (kg == 0) { wtot[(wave * 64 + nb * 16 + n16) * 2] = wA; wtot[(wave * 64 + nb * 16 + n16) * 2 + 1] = wH; }
        }
        __syncthreads();
        bf16_t* hloc = (bf16_t*)(ws + WS_HLOC) + (size_t)d * MT * 256; bf16_t* cuma = (bf16_t*)(ws + WS_CUMA) + (size_t)d * MT * 256;
        float* tcar = (float*)(ws + WS_TCAR) + ((size_t)(d * 144 + tile) * 256 + hd * 64) * 2;
#pragma unroll
        for (int nb = 0; nb < 4; ++nb) { const int c = nb * 16 + n16;
            float xA = 1.f, xH = 0.f;
            if (!rev) { for (int w = 0; w < wave; ++w) { const float wa = wtot[(w * 64 + c) * 2], wh = wtot[(w * 64 + c) * 2 + 1]; xH = wa * xH + wh; xA = xA * wa; } }
            else { for (int w = 7; w > wave; --w) { const float wa = wtot[(w * 64 + c) * 2], wh = wtot[(w * 64 + c) * 2 + 1]; xH = wa * xH + wh; xA = xA * wa; } }
#pragma unroll
            for (int mb = 0; mb < 2; ++mb)
#pragma unroll
                for (int e = 0; e < 4; ++e) { const float hv = A_[mb][nb][e] * xH + H_[mb][nb][e], cv = A_[mb][nb][e] * xA;
                    otile[(wave * 32 + mb * 16 + kg * 4 + e) * 68 + c] = cvt_pk_bf16(hv, cv); }
            if (wave == (rev ? 0 : 7) && kg == 0) { const float wa = wtot[(wave * 64 + c) * 2], wh = wtot[(wave * 64 + c) * 2 + 1];
                tcar[c * 2] = xA * wa; tcar[c * 2 + 1] = wa * xH + wh; }
        }
        __syncthreads();
#pragma unroll
        for (int p = 0; p < 4; ++p) { const int item = tid + 512 * p, t = item >> 3, c8 = (item & 7) * 8;
            const u32x4 w0 = *(const LAS u32x4*)(otile + t * 68 + c8), w1 = *(const LAS u32x4*)(otile + t * 68 + c8 + 4);
            u32x4 ho, co;
            ho.x = (w0.x & 0xffffu) | (w0.y << 16); ho.y = (w0.z & 0xffffu) | (w0.w << 16); ho.z = (w1.x & 0xffffu) | (w1.y << 16); ho.w = (w1.z & 0xffffu) | (w1.w << 16);
            co.x = (w0.x >> 16) | (w0.y & 0xffff0000u); co.y = (w0.z >> 16) | (w0.w & 0xffff0000u); co.z = (w1.x >> 16) | (w1.y & 0xffff0000u); co.w = (w1.z >> 16) | (w1.w & 0xffff0000u);
            const size_t o = ((size_t)tile * 256 + t) * 256 + hd * 64 + c8;
            *(u32x4*)(hloc + o) = ho; *(u32x4*)(cuma + o) = co; }
    }
}

__device__ __forceinline__ void mixer_phase(KAp ap, int l, LAS unsigned char* lds, int tid, int G, int blk) {
    unsigned char* ws = ap->ws;
    const int wave = __builtin_amdgcn_readfirstlane(tid >> 6), lane = tid & 63;
    { LAS float* rpb = (LAS float*)(lds + ATT_RPB_OFF); const float* rp = ap->in[13] + (size_t)l * 3720;
      { float rv[8];
#pragma unroll
        for (int p = 0; p < 8; ++p) { const int i = tid + 512 * p; rv[p] = rp[i < 3720 ? i : 3719]; }
        __builtin_amdgcn_sched_barrier(0);
#pragma unroll
        for (int p = 0; p < 8; ++p) { const int i = tid + 512 * p; if (i < 3720) rpb[i] = rv[p] * LOG2E; } }
      LAS float* mt = (LAS float*)(lds + ATT_MASK_OFF);
      for (int i = tid; i < 6 * 2 * 64 * 4; i += 512) { const int e4 = i & 3, ln = (i >> 2) & 63, part = (i >> 8) & 1, cfg = i >> 9, half = cfg / 3, qb = cfg - 3 * half + half;
          const int kcol = half * 32 + (ln >> 4) * 8 + part * 4 + e4, qcol = qb * 16 + (ln & 15), cs = min(max(qcol - 8, 0), GW - 16);
          mt[i] = (kcol >= cs && kcol < cs + 16) ? 0.f : -3.0e38f; } }
    __syncthreads();
    const bf16_t* U = (const bf16_t*)(ws + WS_U); const bf16_t* VT = (const bf16_t*)(ws + WS_VT); bf16_t* YNA = (bf16_t*)(ws + WS_YNA);
    for (int rep = 0; rep < 1 + ((REPMASK >> 12) & 1); ++rep)
    {
        const int nun = NBATCH * NROWS + (l == 0 ? NBATCH * 4 : 0);
        for (int i = 0; i * G < nun + G; ++i) {
            int un;
            if (G == 256) { const int xcd = blk & 7, jj = blk >> 3;
                if (i < 2) un = ((2 * xcd + i) << 5) + jj; else if (i == 2 && l == 0 && jj < 8) un = NBATCH * NROWS + (2 * xcd + (jj >> 2)) * 4 + (jj & 3); else un = -1; }
            else un = (i * G + blk < nun) ? i * G + blk : -1;
            if (un < 0) continue;
            if (un < NBATCH * NROWS) { const int b = un >> 5, r = un & 31; attn_row(U, VT, YNA, lds, b * SEQ + r * GW, b, r, 8, wave, lane); }
            else { const int q = un - NBATCH * NROWS, b = q >> 2; attn_row(U, VT, YNA, lds, NLAT + b * CTXL + (q & 3) * 64, b, 0, 0, wave, lane); }
        }
    }
#ifndef NO_LRU
    int tid2 = tid; asm volatile("" : "+v"(tid2));
    for (int rep = 0; rep < 1 + ((REPMASK >> 13) & 1); ++rep) {
        if (G == 256) {
            for (int un = blk; un < 512; un += G) lru_unit(ap, l, un >> 2, un & 3, 3, lds, tid2);
            if (blk >= 64 && blk < 192) { const int hu = blk - 64, un = 512 + (hu >> 1); lru_unit(ap, l, un >> 2, un & 3, 1 << (hu & 1), lds, tid2); }
        } else for (int un = blk; un < 144 * 4; un += G) lru_unit(ap, l, un >> 2, un & 3, 3, lds, tid2);
    }
#endif
}

struct MRow { u32x4 y; u32x2 hf, cf, hb, cb, rg, sb, cx[3]; int inm; };
__device__ __forceinline__ void merge_load(MRow& R, const bf16_t* U, const bf16_t* YNA, const bf16_t* hloc, const bf16_t* cuma, int row, int pos, int seglen, int lane) {
    const int c = lane * 4;
    R.y = *(const u32x4*)(YNA + (size_t)row * 512 + lane * 8);
    R.hf = *(const u32x2*)(hloc + (size_t)row * 256 + c); R.cf = *(const u32x2*)(cuma + (size_t)row * 256 + c);
    R.hb = *(const u32x2*)(hloc + (size_t)(MT + row) * 256 + c); R.cb = *(const u32x2*)(cuma + (size_t)(MT + row) * 256 + c);
    const bf16_t* up = U + (size_t)row * UW;
    R.rg = *(const u32x2*)(up + URG + c); R.sb = *(const u32x2*)(up + USB + c);
    R.inm = 0;
#pragma unroll
    for (int k = 0; k < 3; ++k) { const int pp = pos - 1 + k; const bool in = pp >= 0 && pp < seglen; const bf16_t* rp = up + (ptrdiff_t)(in ? k - 1 : 0) * UW;
        R.cx[k] = *(const u32x2*)(rp + UCX + c); R.inm |= in ? (1 << k) : 0; }
}
struct MWts { f32x4 g0, g1, gb, gc, bias, w[3]; };
__device__ __forceinline__ void merge_compute(const MRow& R, unsigned char* MG, float* MS, const MWts& W, const LAS float* car, int row, int lane) {
    float oa[8], ob[4], oc[4];
    { const u32x4 v = R.y; float f[8] = {bf_lo(v.x), bf_hi(v.x), bf_lo(v.y), bf_hi(v.y), bf_lo(v.z), bf_hi(v.z), bf_lo(v.w), bf_hi(v.w)};
      float ss = 0.f;
#pragma unroll
      for (int j = 0; j < 8; ++j) ss += f[j] * f[j];
      ss = wave_sum(ss); const float rs = rsqrtf(ss * (1.0f / 512.0f) + EPSN);
      const f32x4 g0 = W.g0, g1 = W.g1;
#pragma unroll
      for (int j = 0; j < 4; ++j) { oa[j] = f[j] * rs * g0[j]; oa[4 + j] = f[4 + j] * rs * g1[j]; } }
    const int c = lane * 4;
    { const f32x4 kf = *(const LAS f32x4*)(car + c), kb = *(const LAS f32x4*)(car + 256 + c);
      float y[4];
      y[0] = (bf_lo(R.hf.x) + bf_lo(R.cf.x) * kf[0] + bf_lo(R.hb.x) + bf_lo(R.cb.x) * kb[0]) * gelu_tanh(bf_lo(R.rg.x));
      y[1] = (bf_hi(R.hf.x) + bf_hi(R.cf.x) * kf[1] + bf_hi(R.hb.x) + bf_hi(R.cb.x) * kb[1]) * gelu_tanh(bf_hi(R.rg.x));
      y[2] = (bf_lo(R.hf.y) + bf_lo(R.cf.y) * kf[2] + bf_lo(R.hb.y) + bf_lo(R.cb.y) * kb[2]) * gelu_tanh(bf_lo(R.rg.y));
      y[3] = (bf_hi(R.hf.y) + bf_hi(R.cf.y) * kf[3] + bf_hi(R.hb.y) + bf_hi(R.cb.y) * kb[3]) * gelu_tanh(bf_hi(R.rg.y));
      float ss = y[0] * y[0] + y[1] * y[1] + y[2] * y[2] + y[3] * y[3]; ss = wave_sum(ss); const float rs = rsqrtf(ss * (1.0f / 256.0f) + EPSN);
      const f32x4 g0 = W.gb;
#pragma unroll
      for (int j = 0; j < 4; ++j) ob[j] = y[j] * rs * g0[j]; }
    { const f32x4 bias = W.bias; float cv[4] = {bias[0], bias[1], bias[2], bias[3]};
#pragma unroll
      for (int k = 0; k < 3; ++k) { u32x2 cx = R.cx[k]; if (!((R.inm >> k) & 1)) cx = (u32x2){0u, 0u}; const f32x4 w = W.w[k];
          cv[0] += w[0] * bf_lo(cx.x); cv[1] += w[1] * bf_hi(cx.x); cv[2] += w[2] * bf_lo(cx.y); cv[3] += w[3] * bf_hi(cx.y); }
      const u32x2 sb = R.sb;
      float y[4] = {bf_lo(sb.x) * cv[0], bf_hi(sb.x) * cv[1], bf_lo(sb.y) * cv[2], bf_hi(sb.y) * cv[3]};
      float ss = y[0] * y[0] + y[1] * y[1] + y[2] * y[2] + y[3] * y[3]; ss = wave_sum(ss); const float rs = rsqrtf(ss * (1.0f / 256.0f) + EPSN);
      const f32x4 g0 = W.gc;
#pragma unroll
      for (int j = 0; j < 4; ++j) oc[j] = y[j] * rs * g0[j]; }
    float am = 0.f;
#pragma unroll
    for (int j = 0; j < 8; ++j) am = fmaxf(am, fabsf(oa[j]));
#pragma unroll
    for (int j = 0; j < 4; ++j) am = fmaxf(am, fmaxf(fabsf(ob[j]), fabsf(oc[j])));
    am = wave_max(am);
    const float sa = am > 0.f ? am * (1.0f / FP8_TOP) : 1.0f, ia = 1.0f / sa;
    if (lane == 0) MS[row] = sa;
    unsigned char* rp = MG + (size_t)row * D;
    u32x2 qa; qa.x = cvt_fp8x4(oa[0] * ia, oa[1] * ia, oa[2] * ia, oa[3] * ia); qa.y = cvt_fp8x4(oa[4] * ia, oa[5] * ia, oa[6] * ia, oa[7] * ia);
    *(u32x2*)(rp + lane * 8) = qa;
    *(unsigned*)(rp + 512 + c) = cvt_fp8x4(ob[0] * ia, ob[1] * ia, ob[2] * ia, ob[3] * ia);
    *(unsigned*)(rp + 768 + c) = cvt_fp8x4(oc[0] * ia, oc[1] * ia, oc[2] * ia, oc[3] * ia);
}
__device__ __forceinline__ void merge_phase(KAp ap, int l, int ntok, LAS unsigned char* lds, int tid, int G, int blk) {
    unsigned char* ws = ap->ws;
    const int wave = __builtin_amdgcn_readfirstlane(tid >> 6), lane = tid & 63;
    const bf16_t* U = (const bf16_t*)(ws + WS_U); const bf16_t* YNA = (const bf16_t*)(ws + WS_YNA);
    const bf16_t* hloc = (const bf16_t*)(ws + WS_HLOC); const bf16_t* cuma = (const bf16_t*)(ws + WS_CUMA); const float* tcar = (const float*)(ws + WS_TCAR);
    unsigned char* MG = ws + WS_H; float* MS = (float*)(ws + WS_HS);
    const float* og = ap->in[16] + (size_t)l * D;
    const float* scw = ap->in[14] + (size_t)l * 3 * 256; const float* scb = ap->in[15] + (size_t)l * 256;
    LAS float* car = (LAS float*)lds;
    MWts W; { const int c = lane * 4; W.g0 = *(const f32x4*)(og + lane * 8); W.g1 = *(const f32x4*)(og + lane * 8 + 4); W.gb = *(const f32x4*)(og + 512 + c); W.gc = *(const f32x4*)(og + 768 + c);
        W.bias = *(const f32x4*)(scb + c); W.w[0] = *(const f32x4*)(scw + c); W.w[1] = *(const f32x4*)(scw + 256 + c); W.w[2] = *(const f32x4*)(scw + 512 + c); }
    const int chunk = (ntok + G - 1) / G, c0 = blk * chunk, c1 = (c0 + chunk < ntok) ? c0 + chunk : ntok;
    for (int ts = c0; ts < c1; ) {
        const int tile = ts >> 8, te = ((tile + 1) << 8) < c1 ? ((tile + 1) << 8) : c1;
        __syncthreads();
        { const int d = tid >> 8, c = tid & 255; float hst = 0.f;
          if (tile < 128) { const int bb = tile >> 3; const float* tc = tcar + (size_t)d * 144 * 512 + c * 2;
              float pa[8], ph[8]; const int n = d == 0 ? (tile - bb * 8) : (bb * 8 + 7 - tile);
              hst = tc[(size_t)(128 + bb) * 512 + 1];
#pragma unroll
              for (int i = 0; i < 7; ++i) { const int tt = d == 0 ? bb * 8 + i : bb * 8 + 7 - i; const bool on = i < n; pa[i] = on ? tc[(size_t)tt * 512] : 1.f; ph[i] = on ? tc[(size_t)tt * 512 + 1] : 0.f; }
#pragma unroll
              for (int i = 0; i < 7; ++i) hst = pa[i] * hst + ph[i]; }
          car[tid] = hst; }
        __syncthreads();
        const int seglen = tile < 128 ? SEQ : CTXL, pmask = tile < 128 ? 2047 : 255;
        MRow cur, nxt; int row = ts + wave;
        if (row < te) merge_load(cur, U, YNA, hloc, cuma, row, row & pmask, seglen, lane);
        for (; row < te; row += 8) {
            { const int rn = row + 8 < te ? row + 8 : te - 1; merge_load(nxt, U, YNA, hloc, cuma, rn, rn & pmask, seglen, lane); }
            merge_compute(cur, MG, MS, W, car, row, lane);
            cur = nxt;
        }
        ts = te;
    }
}

constexpr int NPHASE = 20;
#ifndef PH_ATTR
#define PH_ATTR __device__ __forceinline__
#endif
PH_ATTR void ph_p0(int wv, LAS unsigned char* lds) { p0_phase(ka_get(), lds, op_tid(), op_grid(), op_blk()); }
constexpr size_t WS_XTAIL = WS_U + (size_t)MPERM * 1024 * 2;
static_assert(WS_XTAIL + (size_t)NLAT * 1024 * 2 <= WS_C, "bf16 stream tail fits behind HP / Y2 in region U");
PH_ATTR void ph_norm1(int wv, int l, LAS unsigned char* lds) { KAp ka = ka_get(); unsigned char* ws = ka->ws;
    const float* mod = (const float*)(ws + WS_MOD);
    RnArgs A{}; A.gvec = ka->in[6] + (size_t)l * D; A.modl = mod + (size_t)l * 17 * NMODC; A.si = 0; A.H8 = ws + WS_H; A.HS = (float*)(ws + WS_HS); A.ntok = MT;
    if (l == 0) { A.xl = ka->in[0]; A.xc = ka->in[2]; resnorm_phase<0, false, false, false>(A, lds, op_tid(), op_grid(), op_blk()); }
    else { A.xs16 = (const bf16_t*)ka->out; A.xd16 = (bf16_t*)ka->out; A.Y = (const bf16_t*)(ws + WS_U); A.gatev = mod; A.gi = 5;
        A.tokinfo_prev = (const u32x4*)(ws + WS_TOKINFO); A.gcnt_prev = (const unsigned*)(ws + WS_CTL) + CW_CNT;
        resnorm_phase<2, false, false, true>(A, lds, op_tid(), op_grid(), op_blk()); } }
PH_ATTR void ph_inproj(int wv, int l, LAS unsigned char* lds) { KAp ka = ka_get(); unsigned char* ws = ka->ws;
    SchedInproj S{op_grid(), op_blk(), 144, (const char*)(ws + WS_H), (const char*)(ws + WS_WIN) + (size_t)l * 2816 * 1024, l == 1};
    EpiInproj E{(bf16_t*)(ws + WS_U), (bf16_t*)(ws + WS_VT), (const float*)(ws + WS_HS), (const float*)(ws + WS_SWIN) + (size_t)l * 2816};
    pg8::gemm_phase<EpiInproj, SchedInproj, true>(wv, lds, 512, 512, 512, S, E);
    const int blk_ = op_blk(); const bool helper = op_grid() != 256 || blk_ >= (l == 0 ? 48 : 208);
    if (helper) { if (l == 0) { gu8_queue(ka, lds, Q8_WOUT0, Q8_WOUT0 + 32, 0, op_tid()); }
                  } }
PH_ATTR void ph_mixer(int wv, int l, LAS unsigned char* lds) { KAp ka = ka_get(); mixer_phase(ka, l, lds, op_tid(), op_grid(), op_blk());
    if (l == 0) { __syncthreads(); gu8_queue(ka, lds, 0, NGU8_LAYER, 5, op_tid()); }
    if (l == 1) { __syncthreads(); gu8_queue(ka, lds, CH2, 2 * NGU8_LAYER, 8, op_tid()); gu8_queue<true>(ka, lds, NGD8_LAYER, 2 * NGD8_LAYER, 10, op_tid()); } }
PH_ATTR void ph_merge(int wv, int l, LAS unsigned char* lds) { merge_phase(ka_get(), l, (l == 0 ? 144 : 128) * 256, lds, op_tid(), op_grid(), op_blk()); }
PH_ATTR void ph_outproj(int wv, int l, LAS unsigned char* lds) { KAp ka = ka_get(); unsigned char* ws = ka->ws;
    SchedOut S{op_grid(), op_blk(), l == 0 ? 144 : 128, (const char*)(ws + WS_H), (const char*)(ws + WS_WOUT) + (size_t)l * 1024 * 1024};
    EpiStoreRC E{(bf16_t*)(ws + WS_C), (const float*)(ws + WS_HS), (const float*)(ws + WS_SWO) + (size_t)l * 1024};
    pg8::gemm_phase<EpiStoreRC, SchedOut, true>(wv, lds, 512, 512, 512, S, E);
    if (l == 0 && (op_grid() != 256 || op_blk() >= 64)) { gu8_queue<true>(ka, lds, 0, NGD8_LAYER, 9, op_tid()); gu8_queue(ka, lds, Q8_WIN0 + NWIN8_LAYER, Q8_WIN0 + 2 * NWIN8_LAYER, 12, op_tid()); gu8_queue(ka, lds, Q8_WOUT0 + 32, Q8_WOUT0 + 64, 2, op_tid()); gu8_queue(ka, lds, NGU8_LAYER, CH1, 6, op_tid()); } }
PH_ATTR void ph_norm2(int wv, int l, LAS unsigned char* lds, int dummy = 0) { KAp ka = ka_get(); unsigned char* ws = ka->ws;
    const float* mod = (const float*)(ws + WS_MOD);
    RnArgs A{}; A.Y = (const bf16_t*)(ws + WS_C); A.gatev = mod + (size_t)l * 17 * NMODC; A.gi = 2;
    A.gvec = ka->in[18] + (size_t)l * D; A.modl = mod + (size_t)l * 17 * NMODC; A.si = 3; A.H8 = ws + WS_H; A.HS = (float*)(ws + WS_HS); A.rw = (f32x4*)(ws + WS_U) + (dummy ? (size_t)NBUCK * MT : 0); A.ntok = (l == 0 ? 144 : 128) * 256;
    A.wrt = ka->in[19]; A.brt = ka->in[20]; A.gcnt = (unsigned*)(ws + WS_CTL) + CW_CNT + l * 64 + (dummy ? 1024 : 0); A.tokinfo = dummy ? (u32x4*)(ws + WS_TCAR) : (u32x4*)(ws + WS_TOKINFO);
    if (l == 0) { A.xl = ka->in[0]; A.xc = ka->in[2]; A.xd16 = (bf16_t*)ka->out; resnorm_phase<1, true, false, false>(A, lds, op_tid(), op_grid(), op_blk()); }
    else { A.xs16 = (const bf16_t*)ka->out; A.xd16 = (bf16_t*)(ws + WS_XTAIL); resnorm_phase<1, true, false, true>(A, lds, op_tid(), op_grid(), op_blk()); } }
PH_ATTR void ph_permute(int wv, int l, LAS unsigned char* lds) { KAp ka = ka_get(); unsigned char* ws = ka->ws;
    permute_phase(ws + WS_H, (const float*)(ws + WS_HS), ws + WS_U, (const u32x4*)(ws + WS_TOKINFO), (const unsigned*)(ws + WS_CTL) + CW_CNT + l * 64,
                  (f32x4*)(ws + WS_ROWW), (l == 0 ? 144 : 128) * 256, (LAS int*)(lds + LDS_MISC + 256), op_tid(), op_grid(), op_blk()); }
PH_ATTR void ph_gateup(int wv, int l, LAS unsigned char* lds) { KAp ka = ka_get(); unsigned char* ws = ka->ws; LAS int* tst = (LAS int*)(lds + LDS_MISC + 256);
    __syncthreads(); moe_offsets((const unsigned*)(ws + WS_CTL) + CW_CNT + l * 64, tst, op_tid());
    SchedMoe S{op_grid(), op_blk(), 8, tst[NBUCK], tst, (const char*)(ws + WS_H), (const char*)(ws + WS_WGU) + (size_t)l * 16 * 1024 * 1024, 0, (const f32x4*)(ws + WS_U), (const LAS int*)(lds + LDS_MISC + 4096)};
    {
      LAS int* tix = (LAS int*)(lds + LDS_MISC + 4096); const int t_ = op_tid(); int tv[6];
#pragma unroll
      for (int i = 0; i < 6; ++i) { pg8::Unit u_; const bool ok = S.next(i, u_); const int rb = u_.x1 & 0xFFFFF, valid = u_.x1 >> 20;
          tv[i] = (ok && t_ < 256) ? __float_as_int(S.rw[rb + (t_ < valid ? t_ : 0)][3]) : 0; }
      __builtin_amdgcn_sched_barrier(0);
#pragma unroll
      for (int i = 0; i < 6; ++i) if (t_ < 256) tix[i * 256 + t_] = tv[i];
      __syncthreads(); }
    EpiGateUp E{ws + WS_C, (const f32x4*)(ws + WS_U), (const float*)(ws + WS_SGU) + (size_t)l * 16 * 1024, (const float*)(ws + WS_TD) + (size_t)l * 16 * 512};
    pg8::gemm_phase<EpiGateUp, SchedMoe, GU_FP8_MMA, true>(wv, lds, 512, 512, 512, S, E);
    if (l == 0) gu8_queue(ka, lds, CH1, CH2, 7, op_tid()); }
PH_ATTR void ph_down(int wv, int l, LAS unsigned char* lds) { KAp ka = ka_get(); unsigned char* ws = ka->ws; LAS int* tst = (LAS int*)(lds + LDS_MISC + 256);
    __syncthreads(); moe_offsets((const unsigned*)(ws + WS_CTL) + CW_CNT + l * 64, tst, op_tid());
    SchedMoe S{op_grid(), op_blk(), 4, tst[NBUCK], tst, (const char*)(ws + WS_C), (const char*)(ws + WS_WD) + (size_t)l * 16 * 1024 * 512, 1, nullptr, nullptr};
    EpiStoreS E{(bf16_t*)(ws + WS_U), 1.0f / (HID_CH * FP8_TOP)};
    pg8::gemm_phase<EpiStoreS, SchedMoe, true>(wv, lds, 512, 512, 256, S, E);
 }
PH_ATTR void ph_final(int wv, LAS unsigned char* lds) { KAp ka = ka_get(); unsigned char* ws = ka->ws;
    RnArgs A{}; A.xs16 = (const bf16_t*)(ws + WS_XTAIL); A.Y = (const bf16_t*)(ws + WS_U); A.gatev = (const float*)(ws + WS_MOD) + (size_t)17 * NMODC; A.gi = 5;
    A.tokinfo_prev = (const u32x4*)(ws + WS_TOKINFO); A.gcnt_prev = (const unsigned*)(ws + WS_CTL) + CW_CNT + 64;
    A.gvec = ka->in[24]; A.outf = ka->out; A.ntok = NLAT;
    resnorm_phase<2, false, true, true>(A, lds, op_tid(), op_grid(), op_blk()); }

__global__ void __launch_bounds__(512, 2) mk_fwd(KArgs args) {
    extern __shared__ __attribute__((aligned(16))) unsigned char lds_raw[];
    LAS unsigned char* lds = (LAS unsigned char*)lds_raw;
    const int wv = __builtin_amdgcn_readfirstlane((int)threadIdx.x >> 6);
    volatile LAS unsigned* misc = (volatile LAS unsigned*)(lds + LDS_MISC);
    if (wv == 0) misc[lane_id_()] = 0u;
    __syncthreads();
    const int lo = args.ph_lo, hi = args.ph_hi;
    XcdBarrier bar; bar.bar = (unsigned*)(args.ws + WS_CTL) + CW_BAR; bar.x = 0; bar.st = misc;
    if (hi - lo > 1) bar = xcd_barrier_post((unsigned*)(args.ws + WS_CTL) + CW_BAR, misc, wv * 64 + lane_id_());
#ifndef PHMASK
#define PHMASK 0x7ff
#endif
#define IN(k) (((PHMASK >> ((k) == 0 ? 0 : ((k) == 19 ? 10 : 1 + ((k) - 1) % 9))) & 1) && lo <= (k) && (k) < hi)
#define SEAM(k) do { if (IN(k) && IN((k) + 1)) xcd_barrier(bar, op_tid()); } while (0)
#define REP(kind) ((REPMASK >> (kind)) & 1)
    if (IN(0)) { ph_p0(wv, lds); if (REP(0)) { __syncthreads(); ph_p0(wv, lds); } }
    SEAM(0);
#pragma nounroll
    for (int l = 0; l < 2; ++l) {
        const int pb = 1 + 9 * l;
        if (IN(pb + 0)) { ph_norm1(wv, l, lds); if (REP(1) && l == 0) { __syncthreads(); ph_norm1(wv, l, lds); } }
        SEAM(pb + 0);
        if (IN(pb + 1)) { ph_inproj(wv, l, lds); if (REP(2)) { __syncthreads(); ph_inproj(wv, l, lds); } }
        SEAM(pb + 1);
        if (IN(pb + 2)) { ph_mixer(wv, l, lds); if (REP(3)) { __syncthreads(); ph_mixer(wv, l, lds); } }
        SEAM(pb + 2);
        if (IN(pb + 3)) { ph_merge(wv, l, lds); if (REP(4)) { __syncthreads(); ph_merge(wv, l, lds); } }
        SEAM(pb + 3);
        if (IN(pb + 4)) { ph_outproj(wv, l, lds); if (REP(5)) { __syncthreads(); ph_outproj(wv, l, lds); } }
        SEAM(pb + 4);
        if (IN(pb + 5)) { if (REP(6)) { ph_norm2(wv, l, lds, 1); __syncthreads(); } ph_norm2(wv, l, lds); }
        SEAM(pb + 5);
        if (IN(pb + 7)) { ph_gateup(wv, l, lds); if (REP(8)) { __syncthreads(); ph_gateup(wv, l, lds); } }
        SEAM(pb + 7);
        if (IN(pb + 8)) { ph_down(wv, l, lds); if (REP(9)) { __syncthreads(); ph_down(wv, l, lds); } }
        SEAM(pb + 8);
    }
    if (IN(19)) { ph_final(wv, lds); if (REP(10)) { __syncthreads(); ph_final(wv, lds); } }
#undef IN
#undef SEAM
}

extern "C" void kernel_launch(void* const* d_in, const int* in_sizes, int n_in, void* d_out, int out_size, void* d_ws, size_t ws_size, hipStream_t stream) {
    static int grid = 0;
    if (grid == 0) {
        if (n_in != 25 || out_size != NLAT * D || ws_size < WS_END) { fprintf(stderr, "kernel_launch: unexpected shapes (n_in %d out %d ws %zu need %zu)\n", n_in, out_size, ws_size, (size_t)WS_END); grid = -1; return; }
        int dev = 0, cus = 0, per_cu = 0;
        if (hipGetDevice(&dev) != hipSuccess || hipDeviceGetAttribute(&cus, hipDeviceAttributeMultiprocessorCount, dev) != hipSuccess) { grid = -1; return; }
        if (hipFuncSetAttribute((const void*)mk_fwd, hipFuncAttributeMaxDynamicSharedMemorySize, LDS_BYTES) != hipSuccess) { fprintf(stderr, "kernel_launch: hipFuncSetAttribute failed\n"); grid = -1; return; }
        if (hipOccupancyMaxActiveBlocksPerMultiprocessor(&per_cu, (const void*)mk_fwd, 512, LDS_BYTES) != hipSuccess || per_cu < 1) { fprintf(stderr, "kernel_launch: occupancy query says %d\n", per_cu); (void)hipGetLastError(); grid = -1; return; }
        grid = cus;
        if (grid != 256) { fprintf(stderr, "kernel_launch: built for 256 CUs, got %d\n", cus); grid = -1; return; }
    }
    if (grid < 0) return;
    (void)hipMemsetAsync((char*)d_ws + WS_CTL, 0, CTL_BYTES, stream);
    KArgs a{};
    for (int i = 0; i < 25; ++i) a.in[i] = (const float*)d_in[i];
    a.out = (float*)d_out; a.ws = (unsigned char*)d_ws;
#if MK_PER_PHASE
    for (int p = 0; p < NPHASE; ++p) { a.ph_lo = p; a.ph_hi = p + 1; hipLaunchKernelGGL(mk_fwd, dim3(grid), dim3(512), LDS_BYTES, stream, a); }
#else
    a.ph_lo = 0; a.ph_hi = NPHASE;
    hipLaunchKernelGGL(mk_fwd, dim3(grid), dim3(512), LDS_BYTES, stream, a);
#endif
}
```
